# Optimizing an MI355X kernel written in HIP

```python
import jax
import jax.numpy as jnp
from jax import lax
import numpy as np

D_MODEL = 1024
BATCH = 4
SEQ = 4096
DEPTH = 2

HEAD_DIM = 64
BLOCK = 128
NEG_INF = -1e30

A_HEADS = 8
A_KV_HEADS = 2
A_WINDOW = 128
B_HEADS = 8
B_PATTERNS = ((128, 1), (512, 4), (2048, 16))
C_HEADS = 8
IDX_HEADS = 4
IDX_DIM = 64
TOPK_MAX = 256
D_HEADS = 8

N_BRANCH = 4
BRANCH_WIDTH = 8 * HEAD_DIM
N_ALIBI_HEADS = A_HEADS + B_HEADS + C_HEADS

D_FF = 2816
CONV_WIDTH = 3
LN_EPS = 1e-5
DEEPNORM_ALPHA = (2 * DEPTH) ** 0.25
DEEPNORM_BETA = (8 * DEPTH) ** -0.25

IN_SPLIT_SIZES = (
    A_HEADS * HEAD_DIM, A_KV_HEADS * HEAD_DIM, A_KV_HEADS * HEAD_DIM,
    B_HEADS * HEAD_DIM, B_HEADS * HEAD_DIM, B_HEADS * HEAD_DIM,
    C_HEADS * HEAD_DIM, HEAD_DIM, HEAD_DIM, IDX_HEADS * IDX_DIM, IDX_DIM, IDX_HEADS,
    D_HEADS * HEAD_DIM, D_HEADS * HEAD_DIM, D_HEADS * HEAD_DIM, D_HEADS,
)
IN_WIDTH = sum(IN_SPLIT_SIZES)

kernel_name = "hybrid_gated_parallel_mixer_deepnorm"


def layer_norm(x, g, b):
    xf = x.astype(jnp.float32)
    mu = jnp.mean(xf, axis=-1, keepdims=True)
    var = jnp.mean(jnp.square(xf - mu), axis=-1, keepdims=True)
    y = (xf - mu) * lax.rsqrt(var + LN_EPS) * g.astype(jnp.float32) + b.astype(jnp.float32)
    return y.astype(x.dtype)


def alibi_slopes():
    s = jnp.exp2(-8.0 * jnp.arange(1, N_ALIBI_HEADS + 1, dtype=jnp.float32) / N_ALIBI_HEADS)
    return s[0::3], s[1::3], s[2::3]


def banded_attention(q, k, v, slopes, max_dist, dist_scale, sinks=None):
    n, L, hq, hd = q.shape
    hkv = k.shape[2]
    g = hq // hkv
    nb = -(-L // BLOCK)
    pad = nb * BLOCK - L
    if pad:
        cfg = ((0, 0), (0, pad), (0, 0), (0, 0))
        q, k, v = jnp.pad(q, cfg), jnp.pad(k, cfg), jnp.pad(v, cfg)
    qb = q.reshape(n, nb, BLOCK, hkv, g, hd)
    kb = k.reshape(n, nb, BLOCK, hkv, hd)
    vb = v.reshape(n, nb, BLOCK, hkv, hd)
    kk = jnp.concatenate([jnp.concatenate([jnp.zeros_like(kb[:, :1]), kb[:, :-1]], axis=1), kb], axis=2)
    vv = jnp.concatenate([jnp.concatenate([jnp.zeros_like(vb[:, :1]), vb[:, :-1]], axis=1), vb], axis=2)
    s = jnp.einsum('nbqhgd,nbkhd->nbhgqk', qb, kk).astype(jnp.float32) * (hd ** -0.5)
    qi = jnp.arange(BLOCK)[:, None]
    ki = jnp.arange(2 * BLOCK)[None, :]
    dist = qi - ki + BLOCK
    first = (jnp.arange(nb) == 0)[:, None, None]
    valid = (dist >= 0) & (dist <= max_dist) & ~(first & (ki < BLOCK))
    s = s - slopes.reshape(hkv, g)[:, :, None, None] * (dist * dist_scale).astype(jnp.float32)
    s = jnp.where(valid[None, :, None, None], s, NEG_INF)
    m = jnp.max(s, axis=-1)
    if sinks is not None:
        sk = sinks.astype(jnp.float32).reshape(hkv, g)[:, :, None]
        m = jnp.maximum(m, sk)
    p = jnp.exp(s - m[..., None])
    l = jnp.sum(p, axis=-1)
    if sinks is not None:
        l = l + jnp.exp(sk - m)
    p = p / l[..., None]
    o = jnp.einsum('nbhgqk,nbkhd->nbqhgd', p.astype(v.dtype), vv).reshape(n, nb * BLOCK, hq, hd)[:, :L]
    m = m.transpose(0, 1, 4, 2, 3).reshape(n, nb * BLOCK, hq)[:, :L]
    l = l.transpose(0, 1, 4, 2, 3).reshape(n, nb * BLOCK, hq)[:, :L]
    return o, m, l


def dilated_attention(q, k, v, slopes):
    b, L, h, hd = q.shape
    outs, ms, ls = [], [], []
    for window, dil in B_PATTERNS:
        to_cls = lambda t: t.reshape(b, L // dil, dil, h, hd).transpose(0, 2, 1, 3, 4).reshape(b * dil, L // dil, h, hd)
        o, m, l = banded_attention(to_cls(q), to_cls(k), to_cls(v), slopes, window // dil, dil)
        outs.append(o.reshape(b, dil, L // dil, h, hd).transpose(0, 2, 1, 3, 4).reshape(b, L, h, hd))
        ms.append(m.reshape(b, dil, L // dil, h).transpose(0, 2, 1, 3).reshape(b, L, h))
        ls.append(l.reshape(b, dil, L // dil, h).transpose(0, 2, 1, 3).reshape(b, L, h))
    ms = jnp.stack(ms)
    w = jnp.stack(ls) * jnp.exp(ms - jnp.max(ms, axis=0, keepdims=True))
    o = jnp.sum(w[..., None] * jnp.stack(outs).astype(jnp.float32), axis=0) / jnp.sum(w, axis=0)[..., None]
    return o.astype(q.dtype)


def dsa_attention(q, k, v, iq, ik, iw, slopes, topk):
    b, L, h, hd = q.shape
    nb = L // BLOCK
    bidx = jnp.arange(b)[:, None, None]
    kpos = jnp.arange(L)

    def block(i):
        start = i * BLOCK
        qb = lax.dynamic_slice_in_dim(q, start, BLOCK, axis=1)
        iqb = lax.dynamic_slice_in_dim(iq, start, BLOCK, axis=1)
        iwb = lax.dynamic_slice_in_dim(iw, start, BLOCK, axis=1)
        qpos = start + jnp.arange(BLOCK)
        rel = jax.nn.relu(jnp.einsum('bqhd,bsd->bqhs', iqb, ik).astype(jnp.float32) * (IDX_DIM ** -0.5))
        score = jnp.einsum('bqh,bqhs->bqs', iwb.astype(jnp.float32), rel)
        score = jnp.where((kpos[None, :] <= qpos[:, None])[None], score, NEG_INF)
        _, idx = lax.top_k(score, topk)
        valid = idx <= qpos[None, :, None]
        kg = k[bidx, idx]
        vg = v[bidx, idx]
        s = jnp.einsum('bqhd,bqkd->bhqk', qb, kg).astype(jnp.float32) * (hd ** -0.5)
        dist = (qpos[None, :, None] - idx).astype(jnp.float32)
        s = s - slopes[None, :, None, None] * dist[:, None]
        s = jnp.where(valid[:, None], s, NEG_INF)
        p = jax.nn.softmax(s, axis=-1)
        return jnp.einsum('bhqk,bqkd->bqhd', p.astype(v.dtype), vg)

    o = lax.map(block, jnp.arange(nb))
    return o.transpose(1, 0, 2, 3, 4).reshape(b, L, h, hd)


def forgetting_attention(q, k, v, f_logit):
    b, L, h, hd = q.shape
    nb = L // BLOCK
    c = jnp.cumsum(jax.nn.log_sigmoid(f_logit.astype(jnp.float32)), axis=1).transpose(0, 2, 1)
    kpos = jnp.arange(L)

    def block(i):
        start = i * BLOCK
        qb = lax.dynamic_slice_in_dim(q, start, BLOCK, axis=1)
        cq = lax.dynamic_slice_in_dim(c, start, BLOCK, axis=2)
        qpos = start + jnp.arange(BLOCK)
        s = jnp.einsum('bqhd,bshd->bhqs', qb, k).astype(jnp.float32) * (hd ** -0.5)
        s = s + cq[..., None] - c[:, :, None, :]
        s = jnp.where((kpos[None, :] <= qpos[:, None])[None, None], s, NEG_INF)
        p = jax.nn.softmax(s, axis=-1)
        return jnp.einsum('bhqs,bshd->bqhd', p.astype(v.dtype), v)

    o = lax.map(block, jnp.arange(nb))
    return o.transpose(1, 0, 2, 3, 4).reshape(b, L, h, hd)


def token_mixer(x, w_in, b_forget, sinks, w_branch, w_gate, b_gate, w_out):
    b, L, _ = x.shape
    offsets = np.cumsum(IN_SPLIT_SIZES)[:-1].tolist()
    (aq, ak, av, bq, bk, bv, cq, ck, cv, ciq, cik, ciw, dq, dk, dv, df) = jnp.split(x @ w_in, offsets, axis=-1)
    heads = lambda t, n: t.reshape(b, L, n, HEAD_DIM)
    slopes_a, slopes_b, slopes_c = alibi_slopes()
    topk = min(TOPK_MAX, L // 4)
    o_a, _, _ = banded_attention(heads(aq, A_HEADS), heads(ak, A_KV_HEADS), heads(av, A_KV_HEADS),
                                 slopes_a, A_WINDOW - 1, 1, sinks)
    o_b = dilated_attention(heads(bq, B_HEADS), heads(bk, B_HEADS), heads(bv, B_HEADS), slopes_b)
    o_c = dsa_attention(heads(cq, C_HEADS), ck, cv, ciq.reshape(b, L, IDX_HEADS, IDX_DIM), cik, ciw,
                        slopes_c, topk)
    o_d = forgetting_attention(heads(dq, D_HEADS), heads(dk, D_HEADS), heads(dv, D_HEADS), df + b_forget)
    branches = jnp.stack([o.reshape(b, L, BRANCH_WIDTH) for o in (o_a, o_b, o_c, o_d)], axis=2)
    proj = jnp.einsum('bsnk,nkd->bsnd', branches, w_branch)
    gates = jax.nn.sigmoid(x @ w_gate + b_gate).reshape(b, L, N_BRANCH, D_MODEL)
    merged = jnp.sum(gates * proj, axis=2)
    return merged @ w_out


def conv_glu_ffn(x, w_up, w_ffn_gate, conv_w, conv_b, w_down):
    L = x.shape[1]
    a = x @ w_up
    ap = jnp.pad(a, ((0, 0), (CONV_WIDTH - 1, 0), (0, 0)))
    a = conv_b + sum(conv_w[j] * ap[:, j:j + L] for j in range(CONV_WIDTH))
    return (jax.nn.gelu(a) * (x @ w_ffn_gate)) @ w_down


def setup_inputs(seed: int = 0) -> dict:
    key = jax.random.key(seed)
    ks = jax.random.split(key, 17)
    nrm = lambda k, shape, scale: jax.random.normal(k, shape, jnp.float32) * scale
    return {
        "x": nrm(ks[0], (BATCH, SEQ, D_MODEL), 1.0),
        "w_in": nrm(ks[1], (DEPTH, D_MODEL, IN_WIDTH), D_MODEL ** -0.5),
        "b_forget": jnp.linspace(1.0, 6.0, D_HEADS, dtype=jnp.float32)[None] + nrm(ks[2], (DEPTH, D_HEADS), 0.1),
        "sinks": nrm(ks[3], (DEPTH, A_HEADS), 0.5),
        "w_branch": nrm(ks[4], (DEPTH, N_BRANCH, BRANCH_WIDTH, D_MODEL), BRANCH_WIDTH ** -0.5),
        "w_gate": nrm(ks[5], (DEPTH, D_MODEL, N_BRANCH * D_MODEL), D_MODEL ** -0.5),
        "b_gate": nrm(ks[6], (DEPTH, N_BRANCH * D_MODEL), 0.1),
        "w_out": nrm(ks[7], (DEPTH, D_MODEL, D_MODEL), DEEPNORM_BETA * D_MODEL ** -0.5),
        "ln1_g": 1.0 + nrm(ks[8], (DEPTH, D_MODEL), 0.02),
        "ln1_b": nrm(ks[9], (DEPTH, D_MODEL), 0.02),
        "w_up": nrm(ks[10], (DEPTH, D_MODEL, D_FF), D_MODEL ** -0.5),
        "w_ffn_gate": nrm(ks[11], (DEPTH, D_MODEL, D_FF), D_MODEL ** -0.5),
        "conv_w": nrm(ks[12], (DEPTH, CONV_WIDTH, D_FF), CONV_WIDTH ** -0.5),
        "conv_b": nrm(ks[13], (DEPTH, D_FF), 0.02),
        "w_down": nrm(ks[14], (DEPTH, D_FF, D_MODEL), DEEPNORM_BETA * D_FF ** -0.5),
        "ln2_g": 1.0 + nrm(ks[15], (DEPTH, D_MODEL), 0.02),
        "ln2_b": nrm(ks[16], (DEPTH, D_MODEL), 0.02),
    }


def reference(x, w_in, b_forget, sinks, w_branch, w_gate, b_gate, w_out, ln1_g, ln1_b,
              w_up, w_ffn_gate, conv_w, conv_b, w_down, ln2_g, ln2_b):
    for l in range(DEPTH):
        y = token_mixer(x, w_in[l], b_forget[l], sinks[l], w_branch[l], w_gate[l], b_gate[l], w_out[l])
        x = layer_norm(DEEPNORM_ALPHA * x + y, ln1_g[l], ln1_b[l])
        y = conv_glu_ffn(x, w_up[l], w_ffn_gate[l], conv_w[l], conv_b[l], w_down[l])
        x = layer_norm(DEEPNORM_ALPHA * x + y, ln2_g[l], ln2_b[l])
    return x
```

```cpp
#include <hip/hip_runtime.h>
#include <hip/hip_cooperative_groups.h>
#include <hip/hip_bf16.h>
#include <cstdio>
#include <cstdint>
#include <cmath>
namespace cg = cooperative_groups;

namespace pg8 {
#define PG8_LAS __attribute__((address_space(3)))
typedef unsigned short bf16_t;
typedef short bf16x8 __attribute__((ext_vector_type(8)));
typedef float f32x4 __attribute__((ext_vector_type(4)));
typedef float f32x2 __attribute__((ext_vector_type(2)));
typedef unsigned u32x4 __attribute__((ext_vector_type(4)));
typedef unsigned u32x2 __attribute__((ext_vector_type(2)));
constexpr int BM = 256, BK = 64, HALF = 128, HTB = HALF * BK * 2, STAGE_BYTES = 8 * HTB, NXCD = 8, WGM = 8;

__host__ __device__ __forceinline__ int lds_byte(int r, int c) { const int st = (r >> 4) * 2 + (c >> 5), rr = r & 15, cc = c & 31, ob = rr * 64 + cc * 2; return st * 1024 + (ob ^ (((ob >> 9) & 1) << 5)); }
__host__ __device__ __forceinline__ void stage_rc(int b, int& R, int& C) { const int st = b / 1024, sb = b % 1024, swz = sb ^ (((sb >> 9) & 1) << 5); R = (st >> 1) * 16 + swz / 64; C = (st & 1) * 32 + (swz % 64) / 2; }
__host__ __device__ __forceinline__ int perm32(int rho) { const int n = rho >> 4, i = rho & 15; return 8 * (i >> 2) + 4 * n + (i & 3); }

struct Unit { int pm, pn; };
struct Gemm { const bf16_t* A; const bf16_t* Bt; int lda, K; };

struct StaticOrder {
    int nM, nN, nwg, G, c;
    __host__ __device__ void init(int M, int N, int G_, int c_) { nM = M / BM; nN = N / BM; nwg = nM * nN; G = G_; c = c_; }
    __host__ __device__ bool next(int i, Unit& u) const {
        const long L = (long)i * G + c; if (L >= nwg) return false;
        int wgid = (int)L; { const int q = nwg / NXCD, r = nwg % NXCD, xcd = wgid % NXCD, off = wgid / NXCD; wgid = (xcd < r ? xcd * (q + 1) : r * (q + 1) + (xcd - r) * q) + off; }
        const int nig = WGM * nN, gid = wgid / nig, fm = gid * WGM, gsz = (nM - fm) < WGM ? (nM - fm) : WGM;
        u.pm = fm + ((wgid % nig) % gsz); u.pn = (wgid % nig) / gsz; return true;
    }
};
struct FixedUnit {
    Unit u0; bool have;
    __host__ __device__ bool next(int i, Unit& u) const { if (i != 0 || !have) return false; u = u0; return true; }
};

__device__ __forceinline__ unsigned cvt_pk_bf16(float lo, float hi) { unsigned r; asm volatile("v_cvt_pk_bf16_f32 %0, %1, %2" : "=v"(r) : "v"(lo), "v"(hi)); return r; }
__device__ __forceinline__ float bf_lo(unsigned w) { return __uint_as_float(w << 16); }
__device__ __forceinline__ float bf_hi(unsigned w) { return __uint_as_float(w & 0xffff0000u); }

struct EpiBf16 {
    static constexpr bool PERM = true;
    bf16_t* O; int ldc; float* side; int side_pn;
    __device__ __forceinline__ void operator()(const f32x4 (&acc)[2][2][4][2], const Unit& u, int wr, int wc, int fr, int fq) const {
        const int row0 = u.pm * BM + wr * 64 + fr; const int col0 = u.pn * BM + wc * 32 + 8 * fq;
        const bool sd = (side != nullptr) && (u.pn == side_pn) && (wc == 2) && (fq < 2);
#pragma unroll
        for (int ai = 0; ai < 2; ++ai)
#pragma unroll
            for (int m = 0; m < 4; ++m) { const int row = row0 + ai * HALF + m * 16; bf16_t* rowp = O + (size_t)row * ldc + col0;
#pragma unroll
                for (int bj = 0; bj < 2; ++bj) { const f32x4 v0 = acc[ai][bj][m][0], v1 = acc[ai][bj][m][1];
                    u32x4 w; w.x = cvt_pk_bf16(v0[0], v0[1]); w.y = cvt_pk_bf16(v0[2], v0[3]); w.z = cvt_pk_bf16(v1[0], v1[1]); w.w = cvt_pk_bf16(v1[2], v1[3]);
                    *(u32x4*)(rowp + bj * HALF) = w;
                    if (bj == 1 && sd) { float* sp = side + (size_t)row * 16 + 8 * fq; *(f32x4*)sp = v0; if (fq == 0) *(f32x4*)(sp + 4) = v1; } } }
    }
};
__device__ __forceinline__ u32x4* scr_slot(unsigned char* base, int k, int tid) { return (u32x4*)(base + (size_t)(k * 512 + tid) * 16); }
struct EpiGate {
    static constexpr bool PERM = true;
    unsigned char* scr; const float* bias;
    __device__ __forceinline__ void operator()(const f32x4 (&acc)[2][2][4][2], const Unit& u, int wr, int wc, int fr, int fq) const {
        int tid = threadIdx.x; asm volatile("" : "+v"(tid));
        const int col0 = u.pn * BM + wc * 32 + 8 * fq;
        f32x4 bv[2][2];
#pragma unroll
        for (int bj = 0; bj < 2; ++bj)
#pragma unroll
            for (int n = 0; n < 2; ++n) bv[bj][n] = *(const f32x4*)(bias + col0 + bj * HALF + 4 * n);
#pragma unroll
        for (int ai = 0; ai < 2; ++ai)
#pragma unroll
            for (int m = 0; m < 4; ++m)
#pragma unroll
                for (int bj = 0; bj < 2; ++bj) { f32x4 v0 = acc[ai][bj][m][0] + bv[bj][0], v1 = acc[ai][bj][m][1] + bv[bj][1];
#pragma unroll
                    for (int e = 0; e < 4; ++e) { v0[e] = __builtin_amdgcn_rcpf(1.f + __builtin_amdgcn_exp2f(-1.4426950408889634f * v0[e])); v1[e] = __builtin_amdgcn_rcpf(1.f + __builtin_amdgcn_exp2f(-1.4426950408889634f * v1[e])); }
                    u32x4 w; w.x = cvt_pk_bf16(v0[0], v0[1]); w.y = cvt_pk_bf16(v0[2], v0[3]); w.z = cvt_pk_bf16(v1[0], v1[1]); w.w = cvt_pk_bf16(v1[2], v1[3]);
                    *scr_slot(scr, (ai * 4 + m) * 2 + bj, tid) = w; asm volatile("" ::: "memory"); }
    }
};
struct EpiProj {
    static constexpr bool PERM = true;
    unsigned char* scr; bf16_t* Mg; int ldc; int first;
    __device__ __forceinline__ void operator()(const f32x4 (&acc)[2][2][4][2], const Unit& u, int wr, int wc, int fr, int fq) const {
        int tid = threadIdx.x; int row0 = u.pm * BM + wr * 64 + fr; asm volatile("" : "+v"(tid), "+v"(row0)); const int col0 = u.pn * BM + wc * 32 + 8 * fq;
#pragma unroll
        for (int ai = 0; ai < 2; ++ai)
#pragma unroll
            for (int m = 0; m < 4; ++m) { bf16_t* rowp = Mg + (size_t)(row0 + ai * HALF + m * 16) * ldc + col0;
#pragma unroll
                for (int bj = 0; bj < 2; ++bj) { const u32x4 gw = *scr_slot(scr, (ai * 4 + m) * 2 + bj, tid);
                    f32x4 v0 = acc[ai][bj][m][0], v1 = acc[ai][bj][m][1];
                    v0[0] *= bf_lo(gw.x); v0[1] *= bf_hi(gw.x); v0[2] *= bf_lo(gw.y); v0[3] *= bf_hi(gw.y); v1[0] *= bf_lo(gw.z); v1[1] *= bf_hi(gw.z); v1[2] *= bf_lo(gw.w); v1[3] *= bf_hi(gw.w);
                    if (!first) { const u32x4 ow = *(const u32x4*)(rowp + bj * HALF);
                        v0[0] += bf_lo(ow.x); v0[1] += bf_hi(ow.x); v0[2] += bf_lo(ow.y); v0[3] += bf_hi(ow.y); v1[0] += bf_lo(ow.z); v1[1] += bf_hi(ow.z); v1[2] += bf_lo(ow.w); v1[3] += bf_hi(ow.w); }
                    u32x4 w; w.x = cvt_pk_bf16(v0[0], v0[1]); w.y = cvt_pk_bf16(v0[2], v0[3]); w.z = cvt_pk_bf16(v1[0], v1[1]); w.w = cvt_pk_bf16(v1[2], v1[3]);
                    *(u32x4*)(rowp + bj * HALF) = w; asm volatile("" ::: "memory"); } }
    }
};
struct EpiResF32 {
    static constexpr bool PERM = false;
    const bf16_t* res; int ldr; float* out; int ldc; float alpha;
    __device__ __forceinline__ void operator()(const f32x4 (&acc)[2][2][4][2], const Unit& u, int wr, int wc, int fr, int fq) const {
        const int row0 = u.pm * BM + wr * 64 + fr; const int col0 = u.pn * BM + wc * 32 + 4 * fq;
#pragma unroll
        for (int ai = 0; ai < 2; ++ai)
#pragma unroll
            for (int m = 0; m < 4; ++m) { const int row = row0 + ai * HALF + m * 16;
#pragma unroll
                for (int bj = 0; bj < 2; ++bj)
#pragma unroll
                    for (int n = 0; n < 2; ++n) { const int c = col0 + bj * HALF + n * 16; const u32x2 rw = *(const u32x2*)(res + (size_t)row * ldr + c);
                        f32x4 o = acc[ai][bj][m][n]; o[0] += alpha * bf_lo(rw.x); o[1] += alpha * bf_hi(rw.x); o[2] += alpha * bf_lo(rw.y); o[3] += alpha * bf_hi(rw.y);
                        *(f32x4*)(out + (size_t)row * ldc + c) = o; } }
    }
};

template <class Epi, class Sched, bool ALIGN_EPI>
__device__ __forceinline__ void gemm_phase(PG8_LAS unsigned char* lds, const Gemm g, const Sched& S, const Epi& E) {
    int tid_ = threadIdx.x; asm volatile("" : "+v"(tid_));
    const int tid = tid_, wid = __builtin_amdgcn_readfirstlane(tid >> 6), lane = tid & 63, wr = wid >> 2, wc = wid & 3, fr = lane & 15, fq = lane >> 4;
    const int K = g.K, nt = K / BK, lda = g.lda;
    unsigned voffA[2], voffB[2];
#pragma unroll
    for (int i = 0; i < 2; ++i) { int R, C; stage_rc(tid * 16 + i * 8192, R, C); const int Rb = Epi::PERM ? ((R & ~31) + perm32(R & 31)) : R;
        voffA[i] = (unsigned)(R * lda + C) * 2u; voffB[i] = (unsigned)(Rb * K + C) * 2u; }
    const size_t kstep = (size_t)(BK * 2);
    const size_t hstepA = (size_t)HALF * lda * 2, hstepB = (size_t)HALF * K * 2;
    const size_t tstepA = 2 * hstepA, tstepB = 2 * hstepB;
    const unsigned ldsw = (unsigned)wid * 1024u;
    const int aoff = lds_byte(wr * 64 + fr, fq * 8), boff = lds_byte(wc * 32 + fr, fq * 8);
#define PG8_SA(b, h) (((b) * 2 + (h)) * HTB)
#define PG8_SB(b, h) ((4 + (b) * 2 + (h)) * HTB)
#define PG8_STAGE(bufoff, gbase, voff) do { _Pragma("unroll") for (int _i = 0; _i < 2; ++_i) \
        __builtin_amdgcn_global_load_lds((const unsigned*)((const char*)(gbase) + (voff)[_i]), (PG8_LAS unsigned*)(lds + (bufoff) + ldsw + _i * 8192), 16, 0, 0); } while (0)
#define PG8_LDA(dst, b, h) do { _Pragma("unroll") for (int m = 0; m < 4; ++m) _Pragma("unroll") for (int k = 0; k < 2; ++k) dst[m][k] = *(const PG8_LAS bf16x8*)(lds + PG8_SA(b, h) + aoff + m * 2048 + k * 1024); } while (0)
#define PG8_LDB(dst, b, h) do { _Pragma("unroll") for (int n = 0; n < 2; ++n) _Pragma("unroll") for (int k = 0; k < 2; ++k) dst[n][k] = *(const PG8_LAS bf16x8*)(lds + PG8_SB(b, h) + boff + n * 2048 + k * 1024); } while (0)
#define PG8_MMA(ai, bj, At, Bt) do { __builtin_amdgcn_s_setprio(1); _Pragma("unroll") for (int m = 0; m < 4; ++m) _Pragma("unroll") for (int n = 0; n < 2; ++n) _Pragma("unroll") for (int k = 0; k < 2; ++k) \
        acc[ai][bj][m][n] = __builtin_amdgcn_mfma_f32_16x16x32_bf16(Bt[n][k], At[m][k], acc[ai][bj][m][n], 0, 0, 0); __builtin_amdgcn_s_setprio(0); } while (0)
#define PG8_WAIT_V(n) asm volatile("s_waitcnt vmcnt(" #n ")" ::: "memory")
#define PG8_WAIT_L(n) asm volatile("s_waitcnt lgkmcnt(" #n ")" ::: "memory")
#define PG8_BAR __builtin_amdgcn_s_barrier()
#define PG8_SCHED __builtin_amdgcn_sched_barrier(0)
    Unit cur, nxt; int ui = 0;
    if (!S.next(0, cur)) return;
    f32x4 acc[2][2][4][2];
#pragma unroll
    for (int a = 0; a < 2; ++a)
#pragma unroll
        for (int b = 0; b < 2; ++b)
#pragma unroll
            for (int m = 0; m < 4; ++m)
#pragma unroll
                for (int n = 0; n < 2; ++n) acc[a][b][m][n] = (f32x4){0.f, 0.f, 0.f, 0.f};
    bf16x8 At[4][2], B0[2][2], B1[2][2];
    const char* cA = (const char*)g.A + (size_t)cur.pm * tstepA; const char* cB = (const char*)g.Bt + (size_t)cur.pn * tstepB;
    PG8_STAGE(PG8_SB(0, 0), cB, voffB); PG8_STAGE(PG8_SB(0, 1), cB + hstepB, voffB); PG8_STAGE(PG8_SA(0, 0), cA, voffA); PG8_STAGE(PG8_SA(0, 1), cA + hstepA, voffA);
    if (wr == 1) PG8_BAR;
    PG8_WAIT_V(2); PG8_BAR;
    PG8_STAGE(PG8_SB(1, 0), cB + kstep, voffB); PG8_STAGE(PG8_SA(1, 0), cA + kstep, voffA); PG8_STAGE(PG8_SB(1, 1), cB + hstepB + kstep, voffB);
    PG8_WAIT_V(6); PG8_BAR;
    for (;;) {
        const bool has_next = S.next(ui + 1, nxt);
        const char* nA = has_next ? (const char*)g.A + (size_t)nxt.pm * tstepA : cA; const char* nB = has_next ? (const char*)g.Bt + (size_t)nxt.pn * tstepB : cB;
        for (int t = 0; t < nt; t += 2) {
            const bool last = (t == nt - 2);
            const char* a1 = cA + (size_t)(t + 1) * kstep;
            const char* a2 = last ? nA : cA + (size_t)(t + 2) * kstep; const char* b2 = last ? nB : cB + (size_t)(t + 2) * kstep;
            const char* a3 = a2 + kstep; const char* b3 = b2 + kstep;
            PG8_LDB(B0, 0, 0); PG8_LDB(B1, 0, 1); PG8_SCHED; PG8_LDA(At, 0, 0); PG8_STAGE(PG8_SA(1, 1), a1 + hstepA, voffA);
            PG8_WAIT_V(8); PG8_WAIT_L(0); PG8_BAR; PG8_MMA(0, 0, At, B0); PG8_MMA(0, 1, At, B1); PG8_BAR; PG8_SCHED;
            PG8_LDA(At, 0, 1); PG8_STAGE(PG8_SB(0, 0), b2, voffB); PG8_STAGE(PG8_SB(0, 1), b2 + hstepB, voffB); PG8_STAGE(PG8_SA(0, 0), a2, voffA);
            PG8_WAIT_V(8); PG8_WAIT_L(0); PG8_BAR; PG8_MMA(1, 0, At, B0); PG8_MMA(1, 1, At, B1); PG8_BAR; PG8_SCHED;
            PG8_LDB(B0, 1, 0); PG8_LDB(B1, 1, 1); PG8_SCHED; PG8_LDA(At, 1, 0); PG8_STAGE(PG8_SA(0, 1), a2 + hstepA, voffA);
            PG8_WAIT_V(8); PG8_WAIT_L(0); PG8_BAR; PG8_MMA(0, 0, At, B0); PG8_MMA(0, 1, At, B1); PG8_BAR; PG8_SCHED;
            PG8_LDA(At, 1, 1); PG8_STAGE(PG8_SB(1, 0), b3, voffB); PG8_STAGE(PG8_SB(1, 1), b3 + hstepB, voffB); PG8_STAGE(PG8_SA(1, 0), a3, voffA);
            PG8_WAIT_V(8); PG8_WAIT_L(0); PG8_BAR; PG8_MMA(1, 0, At, B0); PG8_MMA(1, 1, At, B1); PG8_BAR; PG8_SCHED;
        }
        if constexpr (ALIGN_EPI) { if (wr == 0) PG8_BAR; }
        E(acc, cur, wr, wc, fr, fq);
        if (!has_next) break;
#pragma unroll
        for (int a = 0; a < 2; ++a)
#pragma unroll
            for (int b = 0; b < 2; ++b)
#pragma unroll
                for (int m = 0; m < 4; ++m)
#pragma unroll
                    for (int n = 0; n < 2; ++n) acc[a][b][m][n] = (f32x4){0.f, 0.f, 0.f, 0.f};
        cur = nxt; cA = nA; cB = nB; ++ui;
        if constexpr (ALIGN_EPI) { if (wr == 1) PG8_BAR; }
    }
    PG8_WAIT_V(0);
    if constexpr (!ALIGN_EPI) { if (wr == 0) PG8_BAR; }
    PG8_BAR;
#undef PG8_SA
#undef PG8_SB
#undef PG8_STAGE
#undef PG8_LDA
#undef PG8_LDB
#undef PG8_MMA
#undef PG8_WAIT_V
#undef PG8_WAIT_L
#undef PG8_BAR
#undef PG8_SCHED
}
}
namespace fox {
using bf16=__hip_bfloat16;
using bf16x8=__attribute__((ext_vector_type(8)))short;
using s16x4=__attribute__((ext_vector_type(4)))short;
using f32x16=__attribute__((ext_vector_type(16)))float;
using u32x4=__attribute__((ext_vector_type(4)))unsigned;
constexpr int BATCH=4,NHEAD=8,SEQ=4096,D=64,DM=4864;
constexpr int NW=8,QBLK=32,QB=QBLK*NW,KVBLK=64,NQB=SEQ/QB;
constexpr int ATTN_PITCH=DM, ATTN_UNIT_ROWS=QB;
__device__ __forceinline__ int crow(int r,int hi){return (r&3)+8*(r>>2)+4*hi;}
#define SBAR() __builtin_amdgcn_sched_barrier(0)
__device__ __forceinline__ void cmask(f32x16&p0,f32x16&p1,int jb,int qrel,int hi){
  const float NEG=-INFINITY; int kb=64*jb+4*hi;
  #pragma unroll
  for(int r=0;r<16;++r){int kv=kb+(r&3)+8*(r>>2); if(kv>qrel)p0[r]=NEG; if(kv+32>qrel)p1[r]=NEG;}
}

constexpr int NSLOT=3, SLOTB=8192;
constexpr int LDS_K=0, LDS_V=NSLOT*SLOTB, LDS_WS=2*NSLOT*SLOTB, LDS_OST=LDS_WS+NW*64*4, LDS_BIAS=LDS_OST+NW*4096, LDS_BYTES=LDS_BIAS+SEQ*4;
constexpr float C2=0.125f*1.4426950408889634f;
__device__ __forceinline__ void glds16(const void*gsrc,unsigned lds_dst){unsigned keep;
  asm volatile("s_mov_b32 %0, m0\n\ts_mov_b32 m0, %2\n\ts_nop 0\n\tglobal_load_lds_dwordx4 %1, off\n\ts_mov_b32 m0, %0":"=&s"(keep):"v"(gsrc),"s"(lds_dst):"memory");}
__device__ __forceinline__ float max3f(float a,float b,float c){float r;asm("v_max3_f32 %0, %1, %2, %3":"=v"(r):"v"(a),"v"(b),"v"(c));return r;}
__device__ __forceinline__ float max2f(float a,float b){float r;asm("v_max_f32_e32 %0, %1, %2":"=v"(r):"v"(a),"v"(b));return r;}
__device__ __forceinline__ float fadd_s(float a,float b){float r;asm("v_add_f32_e32 %0, %1, %2":"=v"(r):"v"(a),"v"(b));return r;}
__device__ __forceinline__ float fsub_s(float a,float b){float r;asm("v_sub_f32_e32 %0, %1, %2":"=v"(r):"v"(a),"v"(b));return r;}
typedef float f32x2_t __attribute__((ext_vector_type(2))); typedef __bf16 bf16x2_t __attribute__((ext_vector_type(2)));
__device__ __forceinline__ unsigned cvtpk_s(float lo,float hi){f32x2_t v={lo,hi};bf16x2_t b=__builtin_convertvector(v,bf16x2_t);return __builtin_bit_cast(unsigned,b);}
#define WAIT_BAR(N) asm volatile("s_waitcnt vmcnt(" #N ") lgkmcnt(0)\n\ts_barrier":::"memory")

__device__ __forceinline__ void qkt(f32x16&p0,f32x16&p1,const char*Kslot,const bf16x8*qr,int r32,int hi){
  const char*kb=Kslot+hi*1024+r32*16;
  #pragma unroll
  for(int d0=0;d0<4;++d0){
    const bf16x8 b0=*reinterpret_cast<const bf16x8*>(kb+d0*2048);
    const bf16x8 b1=*reinterpret_cast<const bf16x8*>(kb+d0*2048+512);
    p0=__builtin_amdgcn_mfma_f32_32x32x16_bf16(b0,qr[d0],p0,0,0,0);p1=__builtin_amdgcn_mfma_f32_32x32x16_bf16(b1,qr[d0],p1,0,0,0);}
}
typedef __attribute__((address_space(3))) const char* lds_cptr;
typedef short v4i16_t __attribute__((ext_vector_type(4)));
__device__ __forceinline__ void kload8(bf16x8*kf,lds_cptr kp){
  kf[0]=*(const __attribute__((address_space(3))) bf16x8*)(kp);      kf[1]=*(const __attribute__((address_space(3))) bf16x8*)(kp+512);
  kf[2]=*(const __attribute__((address_space(3))) bf16x8*)(kp+2048); kf[3]=*(const __attribute__((address_space(3))) bf16x8*)(kp+2560);
  kf[4]=*(const __attribute__((address_space(3))) bf16x8*)(kp+4096); kf[5]=*(const __attribute__((address_space(3))) bf16x8*)(kp+4608);
  kf[6]=*(const __attribute__((address_space(3))) bf16x8*)(kp+6144); kf[7]=*(const __attribute__((address_space(3))) bf16x8*)(kp+6656);
}
__device__ __forceinline__ void kload2(bf16x8*kf,lds_cptr kp,int j){ kf[2*j]=*(const __attribute__((address_space(3))) bf16x8*)(kp+j*2048); kf[2*j+1]=*(const __attribute__((address_space(3))) bf16x8*)(kp+j*2048+512); }
__device__ __forceinline__ s16x4 vtr(lds_cptr p){ return __builtin_bit_cast(s16x4,__builtin_amdgcn_ds_read_tr16_b64_v4i16((__attribute__((address_space(3))) v4i16_t*)p)); }
__device__ __forceinline__ float rowmax(const f32x16&p0,const f32x16&p1){
  float a=max3f(p0[0],p0[1],p1[0]),b=max3f(p0[2],p0[3],p1[1]);a=max3f(a,p1[2],p1[3]);
  #pragma unroll
  for(int r=4;r<16;r+=4){a=max3f(a,p0[r],p0[r+1]);b=max3f(b,p0[r+2],p0[r+3]);a=max3f(a,p1[r],p1[r+1]);b=max3f(b,p1[r+2],p1[r+3]);}
  const float m=max2f(a,b);
  auto rr=__builtin_amdgcn_permlane32_swap(__float_as_uint(m),__float_as_uint(m),false,false);
  return max2f(__uint_as_float(rr[0]),__uint_as_float(rr[1]));
}
__device__ __forceinline__ void pv(f32x16*o,int vb,bf16x8 pa0,bf16x8 pa1,bf16x8 pa2,bf16x8 pa3){
  #pragma unroll
  for(int d0=0;d0<2;++d0){s16x4 lo[4],hi[4];
    #pragma unroll
    for(int ks=0;ks<4;++ks){
      asm volatile("ds_read_b64_tr_b16 %0,%1 offset:%c2":"=&v"(lo[ks]):"v"(vb),"i"(d0*4096+ks*1024):"memory");
      asm volatile("ds_read_b64_tr_b16 %0,%1 offset:%c2":"=&v"(hi[ks]):"v"(vb),"i"(d0*4096+ks*1024+512):"memory");}
    asm volatile("s_waitcnt lgkmcnt(0)":::"memory");SBAR();
    #define PK(k) (bf16x8){lo[k][0],lo[k][1],lo[k][2],lo[k][3],hi[k][0],hi[k][1],hi[k][2],hi[k][3]}
    o[d0]=__builtin_amdgcn_mfma_f32_32x32x16_bf16(pa0,PK(0),o[d0],0,0,0);
    o[d0]=__builtin_amdgcn_mfma_f32_32x32x16_bf16(pa1,PK(1),o[d0],0,0,0);
    o[d0]=__builtin_amdgcn_mfma_f32_32x32x16_bf16(pa2,PK(2),o[d0],0,0,0);
    o[d0]=__builtin_amdgcn_mfma_f32_32x32x16_bf16(pa3,PK(3),o[d0],0,0,0);
    #undef PK
  }
}

#ifndef ATTN_STORE16
#define ATTN_STORE16(p,v) (*(u32x4*)(p)=(v))
#endif
template<int THRL> __device__ __forceinline__ void attn_unit(int b,int h,int qb,const bf16*Q,const bf16*__restrict__ K,const bf16*__restrict__ V,bf16*O,const float*__restrict__ cbias,char*shm){
  int tid_=threadIdx.x; asm volatile("":"+v"(tid_));
  const int tid=tid_,lane=tid&63,r32=lane&31,hi=lane>>5; const int wid=__builtin_amdgcn_readfirstlane(tid>>6);
  const long rowbase=(long)b*SEQ; const int q0=qb*QB;
  const bf16*Qw=Q+(rowbase+q0+wid*QBLK)*DM+h*D;
  const bf16*Kh=K+rowbase*DM+h*D,*Vh=V+rowbase*DM+h*D;
  const unsigned lds0=(unsigned)(uintptr_t)shm;
  float*wsf=(float*)(shm+LDS_WS)+wid*64;
  const bf16*ksrc=Kh+(long)lane*DM+wid*8;
  const bf16*vsrc=Vh+(long)(16*(wid&3)+(lane>>2))*DM+(wid>>2)*32+(lane&3)*8;
  const unsigned kdst=lds0+LDS_K+wid*1024, vdst=lds0+LDS_V+wid*1024;
  #define DMA_K(t,slot) glds16(ksrc+(long)(t)*KVBLK*DM,(unsigned)__builtin_amdgcn_readfirstlane(kdst+(slot)))
  #define DMA_V(t,slot) glds16(vsrc+(long)(t)*KVBLK*DM,(unsigned)__builtin_amdgcn_readfirstlane(vdst+(slot)))
  const int vb0=(int)(lds0+LDS_V)+((lane>>4)&1)*32+(lane&3)*8+(4*hi+((lane&15)>>2))*64;
  const char*Kbase=shm+LDS_K; bf16x8 kf[8];
  const lds_cptr shm3=(lds_cptr)shm; const lds_cptr kp0=shm3+LDS_K+hi*1024+r32*16; const lds_cptr vp0=shm3+LDS_V+((lane>>4)&1)*32+(lane&3)*8+(4*hi+((lane&15)>>2))*64;
  const int NT=(q0+QB)/KVBLK;
  typedef float f32x4v __attribute__((ext_vector_type(4)));
  __attribute__((address_space(3))) float* const blds=(__attribute__((address_space(3))) float*)((__attribute__((address_space(3))) char*)shm+LDS_BIAS);
  { const float* cb=cbias+((long)b*NHEAD+h)*SEQ; const int nk=q0+QB;
    for(int i=tid*4;i<nk;i+=2048){ const f32x4v v=*(const f32x4v*)(cb+i); *(__attribute__((address_space(3))) f32x4v*)(blds+i)=v; } }
  #define BINIT(C0,C1,t) do{ const __attribute__((address_space(3))) float* bp_=blds+64*(t)+4*hi; \
     _Pragma("unroll") for(int g_=0;g_<4;++g_){ const f32x4v b0_=*(const __attribute__((address_space(3))) f32x4v*)(bp_+8*g_); const f32x4v b1_=*(const __attribute__((address_space(3))) f32x4v*)(bp_+32+8*g_); \
       _Pragma("unroll") for(int i_=0;i_<4;++i_){ C0[4*g_+i_]=b0_[i_]-mhat; C1[4*g_+i_]=b1_[i_]-mhat; } } }while(0)
  DMA_K(0,0);DMA_V(0,0);DMA_K(1,SLOTB);
  bf16x8 qr[4];
  #pragma unroll
  for(int d0=0;d0<4;++d0)qr[d0]=*reinterpret_cast<const bf16x8*>(&Qw[(long)r32*DM+d0*16+hi*8]);
  float mhat=0.f,l_reg=0.f;f32x16 o[2];o[0]=f32x16{};o[1]=f32x16{};
  const int qrel=wid*QBLK+r32;
  #define CMASK(P0,P1,t) do{int jb_=(t)-(NT-4); if(jb_>=0)cmask(P0,P1,jb_,qrel,hi);}while(0)
  bool resc=false;
  #define START(P0,P1) do{ const float rm=rowmax(P0,P1); resc=false; \
    { const float dl=rm; mhat=fadd_s(mhat,dl); \
      _Pragma("unroll") for(int r=0;r<16;++r){P0[r]=fsub_s(P0[r],dl);P1[r]=fsub_s(P1[r],dl);} \
      } \
    _Pragma("unroll") for(int r=0;r<16;++r)P0[r]=__builtin_amdgcn_exp2f(P0[r]); }while(0)
  #define RESC() do{ if(resc){ asm volatile("s_waitcnt lgkmcnt(0)":::"memory"); \
      _Pragma("unroll") for(int d_=0;d_<2;++d_) _Pragma("unroll") for(int r=0;r<16;++r)o[d_][r]*=wsf[crow(r,hi)]; } }while(0)
  f32x16 pA0,pA1,pB0,pB1;
  int sl_prev=0,sl_cur=0,sl_next=SLOTB;
  #define ROT() do{sl_prev=sl_cur;sl_cur=sl_next;sl_next=(sl_next==(NSLOT-1)*SLOTB)?0:sl_next+SLOTB;}while(0)
  DMA_K(2,2*SLOTB);
  WAIT_BAR(3);
  BINIT(pA0,pA1,0); qkt(pA0,pA1,Kbase,qr,r32,hi);asm volatile("s_nop 15\n\ts_nop 7":"+v"(pA0),"+v"(pA1));CMASK(pA0,pA1,0);
  START(pA0,pA1);
  _Pragma("unroll") for(int r=0;r<16;++r)pA1[r]=__builtin_amdgcn_exp2f(pA1[r]);
  WAIT_BAR(0);
  DMA_K(3,0);DMA_V(1,SLOTB);
  ROT();
  kload8(kf,kp0+sl_cur);
  WAIT_BAR(2);
  s16x4 vlo[8],vhi[8]; u32x4 pw0,pw1,pw2,pw3;
  #define PKW(P,B) cvtpk_s(P[B],P[B+1])
  #define PAF(k) __builtin_bit_cast(bf16x8,pw##k)
  #define VFR(i) (bf16x8){vlo[i][0],vlo[i][1],vlo[i][2],vlo[i][3],vhi[i][0],vhi[i][1],vhi[i][2],vhi[i][3]}
  #define PIN(x) asm volatile("":"+v"(x))
  #define MX3(a,b,c) __builtin_fmaxf(__builtin_fmaxf((a),(b)),(c))
  #define GAPA(MF,A0,A1,A2,A3,W0,W1,PW) do{ MF; sacc+=A0; sacc+=A1; sacc+=A2; sacc+=A3; PIN(sacc); W0; W1; PIN(PW); SBAR(); }while(0)
  #define EX(v) __builtin_amdgcn_exp2f(v)
  #define GAPB(MF,X,B) do{ MF; X[B]=EX(X[B]); X[B+1]=EX(X[B+1]); X[B+2]=EX(X[B+2]); X[B+3]=EX(X[B+3]); PIN(X); SBAR(); }while(0)
  #define VRD(i) do{ vlo[i]=vtr(vp_+(((i)>>2)*4096+((i)&3)*1024)); vhi[i]=vtr(vp_+(((i)>>2)*4096+((i)&3)*1024+512)); }while(0)
  #define KRD(G,j) do{ if(G){ kload2(kf,kp0+sl_next,j); SBAR(); } }while(0)
  #define STEP(C0,C1,P0,P1,t,GK,GV,GL) do{ SBAR(); BINIT(C0,C1,t); SBAR(); \
    const lds_cptr vp_=vp0+sl_prev; \
    VRD(0); SBAR(); float sacc=(P0[0]+P0[1]); \
    GAPA(C0=__builtin_amdgcn_mfma_f32_32x32x16_bf16(kf[0],qr[0],C0,0,0,0), P0[2],P0[3],P0[4],P0[5],     pw0[0]=PKW(P0,0), pw0[1]=PKW(P0,2), pw0); \
    VRD(4); SBAR(); GAPA(C1=__builtin_amdgcn_mfma_f32_32x32x16_bf16(kf[1],qr[0],C1,0,0,0), P0[6],P0[7],P0[8],P0[9],     pw0[2]=PKW(P0,4), pw0[3]=PKW(P0,6), pw0); \
    VRD(1); SBAR(); GAPA(C0=__builtin_amdgcn_mfma_f32_32x32x16_bf16(kf[2],qr[1],C0,0,0,0),   P0[10],P0[11],P0[12],P0[13], pw1[0]=PKW(P0,8), pw1[1]=PKW(P0,10), pw1); \
    VRD(5); SBAR(); GAPA(C1=__builtin_amdgcn_mfma_f32_32x32x16_bf16(kf[3],qr[1],C1,0,0,0),   P0[14],P0[15],P1[0],P1[1],   pw1[2]=PKW(P0,12),pw1[3]=PKW(P0,14), pw1); \
    VRD(2); SBAR(); GAPA(C0=__builtin_amdgcn_mfma_f32_32x32x16_bf16(kf[4],qr[2],C0,0,0,0),   P1[2],P1[3],P1[4],P1[5],     pw2[0]=PKW(P1,0), pw2[1]=PKW(P1,2), pw2); \
    VRD(6); SBAR(); GAPA(C1=__builtin_amdgcn_mfma_f32_32x32x16_bf16(kf[5],qr[2],C1,0,0,0),   P1[6],P1[7],P1[8],P1[9],     pw2[2]=PKW(P1,4), pw2[3]=PKW(P1,6), pw2); \
    VRD(3); SBAR(); GAPA(C0=__builtin_amdgcn_mfma_f32_32x32x16_bf16(kf[6],qr[3],C0,0,0,0),   P1[10],P1[11],P1[12],P1[13], pw3[0]=PKW(P1,8), pw3[1]=PKW(P1,10), pw3); \
    VRD(7); SBAR(); GAPA(C1=__builtin_amdgcn_mfma_f32_32x32x16_bf16(kf[7],qr[3],C1,0,0,0),   P1[14],P1[15],0.f,0.f,       pw3[2]=PKW(P1,12),pw3[3]=PKW(P1,14), pw3); \
    l_reg+=sacc; \
    if(GK){DMA_K((t)+3,sl_cur);} if(GV){DMA_V((t)+1,sl_next);} \
    CMASK(C0,C1,t); \
    { float a=MX3(C0[0],C0[1],C1[0]),b=MX3(C0[2],C0[3],C1[1]); a=MX3(a,C1[2],C1[3]); \
      _Pragma("unroll") for(int r=4;r<16;r+=4){a=MX3(a,C0[r],C0[r+1]);b=MX3(b,C0[r+2],C0[r+3]);a=MX3(a,C1[r],C1[r+1]);b=MX3(b,C1[r+2],C1[r+3]);} \
      float rm=__builtin_fmaxf(a,b); { auto rr=__builtin_amdgcn_permlane32_swap(__float_as_uint(rm),__float_as_uint(rm),false,false); rm=__builtin_fmaxf(__uint_as_float(rr[0]),__uint_as_float(rr[1])); } \
      resc=false; \
      if(__builtin_expect(__any(rm>(float)THRL),0)){ const float dl=__builtin_fmaxf(rm,0.f); mhat+=dl; \
        _Pragma("unroll") for(int r=0;r<16;++r){C0[r]-=dl;C1[r]-=dl;} \
        const float f=__builtin_amdgcn_exp2f(-dl); l_reg*=f; if(hi==0)wsf[r32]=f; resc=true; } } \
    SBAR(); \
    GAPB(o[0]=__builtin_amdgcn_mfma_f32_32x32x16_bf16(PAF(0),VFR(0),o[0],0,0,0), C0,0); \
    GAPB(o[1]=__builtin_amdgcn_mfma_f32_32x32x16_bf16(PAF(0),VFR(4),o[1],0,0,0), C0,4); \
    KRD(GL,0); GAPB(o[0]=__builtin_amdgcn_mfma_f32_32x32x16_bf16(PAF(1),VFR(1),o[0],0,0,0), C0,8); \
    KRD(GL,1); GAPB(o[1]=__builtin_amdgcn_mfma_f32_32x32x16_bf16(PAF(1),VFR(5),o[1],0,0,0), C0,12); \
    KRD(GL,2); GAPB(o[0]=__builtin_amdgcn_mfma_f32_32x32x16_bf16(PAF(2),VFR(2),o[0],0,0,0), C1,0); \
    KRD(GL,3); GAPB(o[1]=__builtin_amdgcn_mfma_f32_32x32x16_bf16(PAF(2),VFR(6),o[1],0,0,0), C1,4); \
    GAPB(o[0]=__builtin_amdgcn_mfma_f32_32x32x16_bf16(PAF(3),VFR(3),o[0],0,0,0), C1,8); \
    GAPB(o[1]=__builtin_amdgcn_mfma_f32_32x32x16_bf16(PAF(3),VFR(7),o[1],0,0,0), C1,12); \
    }while(0)
  int t=1;
  #undef CMASK
  #define CMASK(P0,P1,t) do{}while(0)
  for(;t+5<NT;t+=2){
    STEP(pB0,pB1,pA0,pA1,t,true,true,true);     WAIT_BAR(2); RESC(); ROT();
    STEP(pA0,pA1,pB0,pB1,t+1,true,true,true);   WAIT_BAR(2); RESC(); ROT();
  }
  #undef CMASK
  #define CMASK(P0,P1,t) do{int jb_=(t)-(NT-4); if(jb_>=0)cmask(P0,P1,jb_,qrel,hi);}while(0)
  #define ENDW(tt) do{ if((tt)+3<NT){WAIT_BAR(2);} else if((tt)+2<NT){WAIT_BAR(1);} else {WAIT_BAR(0);} }while(0)
  for(;t+1<NT;t+=2){
    STEP(pB0,pB1,pA0,pA1,t,(t+3<NT),(t+1<NT),(t+1<NT));       ENDW(t);   RESC(); ROT();
    STEP(pA0,pA1,pB0,pB1,t+1,(t+4<NT),(t+2<NT),(t+2<NT));     ENDW(t+1); RESC(); ROT();
  }
  STEP(pB0,pB1,pA0,pA1,NT-1,false,false,false); RESC();
  { float sacc=pB0[0]+pB0[1]; _Pragma("unroll") for(int r=2;r<16;++r)sacc+=pB0[r]; _Pragma("unroll") for(int r=0;r<16;++r)sacc+=pB1[r]; l_reg+=sacc;
    pw0=(u32x4){PKW(pB0,0),PKW(pB0,2),PKW(pB0,4),PKW(pB0,6)};pw1=(u32x4){PKW(pB0,8),PKW(pB0,10),PKW(pB0,12),PKW(pB0,14)};pw2=(u32x4){PKW(pB1,0),PKW(pB1,2),PKW(pB1,4),PKW(pB1,6)};pw3=(u32x4){PKW(pB1,8),PKW(pB1,10),PKW(pB1,12),PKW(pB1,14)};
    SBAR(); pv(o,vb0+sl_cur,PAF(0),PAF(1),PAF(2),PAF(3)); }
  #undef PKW
  #undef PAF
  #undef VFR
  #undef PIN
  #undef MX3
  #undef GAPA
  #undef GAPB
  #undef EX
  #undef VRD
  #undef KRD
  #undef STEP
  #undef ENDW
  {auto rr=__builtin_amdgcn_permlane32_swap(__float_as_uint(l_reg),__float_as_uint(l_reg),false,false);l_reg=__uint_as_float(rr[0])+__uint_as_float(rr[1]);}
  if(hi==0)wsf[32+r32]=l_reg;asm volatile("s_waitcnt lgkmcnt(0)":::"memory");
  float rli[16];
  #pragma unroll
  for(int r=0;r<16;++r)rli[r]=__builtin_amdgcn_rcpf(wsf[32+crow(r,hi)]);
  bf16*Ow=O+(rowbase+q0+wid*QBLK)*DM+h*D;
  { bf16*stg=(bf16*)(shm+LDS_OST)+wid*2048;
    #pragma unroll
    for(int r=0;r<16;++r){const int orow=crow(r,hi);
      #pragma unroll
      for(int d0=0;d0<2;++d0)stg[orow*64+d0*32+r32]=__float2bfloat16(o[d0][r]*rli[r]);}
    asm volatile("s_waitcnt lgkmcnt(0)":::"memory");
    #pragma unroll
    for(int i=0;i<4;++i){const int row=i*8+(lane>>3),ch=lane&7; const u32x4 v=*(const u32x4*)(stg+row*64+ch*8); ATTN_STORE16(Ow+(long)row*DM+ch*8,v);} }
  asm volatile("s_waitcnt lgkmcnt(0)\n\ts_barrier":::"memory");
  #undef DMA_K
  #undef DMA_V
  #undef BINIT
  #undef CMASK
  #undef START
  #undef RESC
  #undef ROT
}
constexpr int ATTN_LDS_BYTES=LDS_BYTES;
#undef SBAR
#undef WAIT_BAR
}
#define LAS __attribute__((address_space(3)))
typedef unsigned short hb16;
typedef unsigned v4u __attribute__((ext_vector_type(4)));
typedef unsigned v2u __attribute__((ext_vector_type(2)));
typedef float f32x4 __attribute__((ext_vector_type(4)));
typedef float f32x16 __attribute__((ext_vector_type(16)));
typedef short bf16x8 __attribute__((ext_vector_type(8)));
typedef short s16x4 __attribute__((ext_vector_type(4)));

constexpr int NB = 4, SEQ = 4096, T = NB * SEQ, DM = 1024, DFF = 2816, QP = 4864, FP = 5632, NLAYER = 2;
constexpr float LOG2E = 1.4426950408889634f;
constexpr float C2 = 0.125f * LOG2E;
constexpr float ALPHA = 1.4142135623730951f;
constexpr float LN_EPS = 1e-5f;
constexpr int COL_QA = 0, COL_QB = 512, COL_QC = 1024, COL_QD = 1536, COL_KA = 2048, COL_VA = 2176, COL_KB = 2304, COL_VB = 2816, COL_KC = 3328, COL_VC = 3392,
              COL_IQ = 3456, COL_IK = 3712, COL_KD = 3776, COL_VD = 4288, COL_IW = 4800, COL_DF = 4804;
constexpr int COL_GSCR = 2048, COL_MRG = 3072;
constexpr size_t MiB = 1u << 20;
constexpr size_t WS_W = 1 * MiB;
constexpr size_t W_IN = 0, W_G = W_IN + (size_t)QP * DM * 2, W_B = W_G + (size_t)4096 * DM * 2, W_O = W_B + (size_t)4 * 1024 * 512 * 2, W_UF = W_O + (size_t)DM * DM * 2, W_D = W_UF + (size_t)FP * DM * 2, W_END = W_D + (size_t)DM * DFF * 2;
static_assert(W_END == 40 * MiB, "weights");
constexpr size_t WS_XB = 41 * MiB, WS_BIG = 73 * MiB, WS_SIDE = 249 * MiB, WS_CB = 250 * MiB, WS_END = 256 * MiB;
static_assert(WS_BIG + (size_t)T * FP * 2 <= WS_SIDE && WS_BIG + (size_t)T * QP * 2 <= WS_SIDE, "big");
constexpr size_t DO_IDX = 0, DO_PU1 = 8 * MiB, DO_PU2 = 24 * MiB, DO_PML1 = 40 * MiB, DO_PML2 = 41 * MiB;
constexpr int LDS_BYTES = 147456;
constexpr int NWAVES = 8;

struct Args { const float* in[17]; float* out; unsigned char* ws; int ph_lo, ph_hi; };
static_assert(sizeof(Args) == 17 * 8 + 8 + 8 + 8, "Args has no padding");
struct Frame {
    LAS unsigned char* lds; int tid, lane, wave, vcu, G;
    float* out; unsigned char* ws;
    __device__ __forceinline__ hb16* Win_t() const { return (hb16*)(ws + WS_W + W_IN); }
    __device__ __forceinline__ hb16* Wg_t() const { return (hb16*)(ws + WS_W + W_G); }
    __device__ __forceinline__ hb16* Wb_t() const { return (hb16*)(ws + WS_W + W_B); }
    __device__ __forceinline__ hb16* Wo_t() const { return (hb16*)(ws + WS_W + W_O); }
    __device__ __forceinline__ hb16* Wuf_t() const { return (hb16*)(ws + WS_W + W_UF); }
    __device__ __forceinline__ hb16* Wd_t() const { return (hb16*)(ws + WS_W + W_D); }
    __device__ __forceinline__ hb16* XB() const { return (hb16*)(ws + WS_XB); }
    __device__ __forceinline__ hb16* BIG() const { return (hb16*)(ws + WS_BIG); }
    __device__ __forceinline__ float* side() const { return (float*)(ws + WS_SIDE); }
    __device__ __forceinline__ float* cb() const { return (float*)(ws + WS_CB); }
    __device__ __forceinline__ unsigned short* idx() const { return (unsigned short*)((unsigned char*)out + DO_IDX); }
    __device__ __forceinline__ hb16* pu1() const { return (hb16*)((unsigned char*)out + DO_PU1); }
    __device__ __forceinline__ hb16* pu2() const { return (hb16*)((unsigned char*)out + DO_PU2); }
    __device__ __forceinline__ float* pml1() const { return (float*)((unsigned char*)out + DO_PML1); }
    __device__ __forceinline__ float* pml2() const { return (float*)((unsigned char*)out + DO_PML2); }
};

__device__ __forceinline__ unsigned f2bf(float f) { unsigned u = __builtin_bit_cast(unsigned, f); return (u + 0x7fffu + ((u >> 16) & 1u)) >> 16; }
__device__ __forceinline__ unsigned pk2(float lo, float hi) { return f2bf(lo) | (f2bf(hi) << 16); }
__device__ __forceinline__ float bfl(unsigned w) { return __uint_as_float(w << 16); }
__device__ __forceinline__ float bfh(unsigned w) { return __uint_as_float(w & 0xffff0000u); }
__device__ __forceinline__ float bf1(hb16 w) { return __uint_as_float((unsigned)w << 16); }
__device__ __forceinline__ float wave_sum(float v) {
#pragma unroll
    for (int o = 1; o < 64; o <<= 1) v += __shfl_xor(v, o);
    return v;
}
__device__ __forceinline__ int crow(int r, int hi) { return (r & 3) + 8 * (r >> 2) + 4 * hi; }
#define LDS_WAIT() asm volatile("s_waitcnt lgkmcnt(0)" ::: "memory")
#define WBAR() __builtin_amdgcn_wave_barrier()
__device__ __forceinline__ s16x4 vtr(const LAS unsigned char* p) { typedef short v4i16_t __attribute__((ext_vector_type(4))); return __builtin_bit_cast(s16x4, __builtin_amdgcn_ds_read_tr16_b64_v4i16((LAS v4i16_t*)p)); }
__device__ __forceinline__ bf16x8 cat8(s16x4 lo, s16x4 hi) { return (bf16x8){lo[0], lo[1], lo[2], lo[3], hi[0], hi[1], hi[2], hi[3]}; }

__device__ __forceinline__ void tr_item(const float* W, int srcN, int K, hb16* WT, int nblk, LAS float* scr, int item, int lane) {
    const int kb = item / nblk, nb = item % nblk, k0 = 64 * kb, n0 = 32 * nb;
#pragma unroll 8
    for (int i = 0; i < 32; ++i) { const int kk = 2 * i + (lane >> 5); scr[kk * 33 + (lane & 31)] = W[(size_t)(k0 + kk) * srcN + n0 + (lane & 31)]; }
    LDS_WAIT(); asm volatile("" ::: "memory");
    const int c = lane & 7;
#pragma unroll
    for (int j = 0; j < 4; ++j) { const int n = (lane >> 3) + 8 * j; const LAS float* s = scr + (8 * c) * 33 + n;
        v4u o; o.x = pk2(s[0 * 33], s[1 * 33]); o.y = pk2(s[2 * 33], s[3 * 33]); o.z = pk2(s[4 * 33], s[5 * 33]); o.w = pk2(s[6 * 33], s[7 * 33]);
        *(v4u*)(WT + (size_t)(n0 + n) * K + k0 + 8 * c) = o; }
    LDS_WAIT(); asm volatile("" ::: "memory");
}
__device__ __forceinline__ int win_src(int n, float& sc) {
    sc = 1.f;
    if (n < 2048) { sc = C2; const int br = n >> 9, o = n & 511; return (br == 0 ? 0 : br == 1 ? 768 : br == 2 ? 2304 : 3268) + o; }
    if (n < 2176) return 512 + (n - 2048);
    if (n < 2304) return 640 + (n - 2176);
    if (n < 2816) return 1280 + (n - 2304);
    if (n < 3328) return 1792 + (n - 2816);
    if (n < 3392) return 2816 + (n - 3328);
    if (n < 3456) return 2880 + (n - 3392);
    if (n < 3712) { sc = 0.125f; return 2944 + (n - 3456); }
    if (n < 3776) return 3200 + (n - 3712);
    if (n < 4288) return 3780 + (n - 3776);
    if (n < 4800) return 4292 + (n - 4288);
    if (n < 4804) return 3264 + (n - 4800);
    if (n < 4812) return 4804 + (n - 4804);
    sc = 0.f; return 0;
}
__device__ __forceinline__ void tr_item_win(const float* W, hb16* WT, LAS float* scr, int item, int lane) {
    constexpr int nblk = QP / 32, K = DM, srcN = 4812;
    const int kb = item / nblk, nb = item % nblk, k0 = 64 * kb, n0 = 32 * nb;
    float sc; const int sn = win_src(n0 + (lane & 31), sc);
#pragma unroll 8
    for (int i = 0; i < 32; ++i) { const int kk = 2 * i + (lane >> 5); scr[kk * 33 + (lane & 31)] = W[(size_t)(k0 + kk) * srcN + sn] * sc; }
    LDS_WAIT(); asm volatile("" ::: "memory");
    const int c = lane & 7;
#pragma unroll
    for (int j = 0; j < 4; ++j) { const int n = (lane >> 3) + 8 * j; const LAS float* s = scr + (8 * c) * 33 + n;
        v4u o; o.x = pk2(s[0 * 33], s[1 * 33]); o.y = pk2(s[2 * 33], s[3 * 33]); o.z = pk2(s[4 * 33], s[5 * 33]); o.w = pk2(s[6 * 33], s[7 * 33]);
        *(v4u*)(WT + (size_t)(n0 + n) * K + k0 + 8 * c) = o; }
    LDS_WAIT(); asm volatile("" ::: "memory");
}
__device__ __forceinline__ void convert_weights(Frame& F, const Args& A, int l) {
    LAS float* scr = (LAS float*)(F.lds + F.wave * 16384);
    const int gw = F.vcu * NWAVES + F.wave, NGW = F.G * NWAVES;
    constexpr int I_IN = 16 * (QP / 32), I_G = 16 * 128, I_B1 = 8 * 32, I_O = 16 * 32, I_U = 16 * 88, I_D = 44 * 32;
    constexpr int NITEMS = I_IN + I_G + 4 * I_B1 + I_O + 2 * I_U + I_D;
    const float* w_in = A.in[1] + (size_t)l * DM * 4812; const float* w_br = A.in[4] + (size_t)l * 4 * 512 * DM; const float* w_g = A.in[5] + (size_t)l * DM * 4096;
    const float* w_o = A.in[7] + (size_t)l * DM * DM; const float* w_up = A.in[10] + (size_t)l * DM * DFF; const float* w_fg = A.in[11] + (size_t)l * DM * DFF; const float* w_dn = A.in[14] + (size_t)l * DFF * DM;
    for (int it = gw; it < NITEMS; it += NGW) {
        int r = it;
        if (r < I_IN) { tr_item_win(w_in, F.Win_t(), scr, r, F.lane); continue; } r -= I_IN;
        if (r < I_G) { tr_item(w_g, 4096, DM, F.Wg_t(), 128, scr, r, F.lane); continue; } r -= I_G;
        if (r < 4 * I_B1) { const int n = r / I_B1; tr_item(w_br + (size_t)n * 512 * DM, DM, 512, F.Wb_t() + (size_t)n * 1024 * 512, 32, scr, r % I_B1, F.lane); continue; } r -= 4 * I_B1;
        if (r < I_O) { tr_item(w_o, DM, DM, F.Wo_t(), 32, scr, r, F.lane); continue; } r -= I_O;
        if (r < I_U) { tr_item(w_up, DFF, DM, F.Wuf_t(), 88, scr, r, F.lane); continue; } r -= I_U;
        if (r < I_U) { tr_item(w_fg, DFF, DM, F.Wuf_t() + (size_t)DFF * DM, 88, scr, r, F.lane); continue; } r -= I_U;
        tr_item(w_dn, DM, DFF, F.Wd_t(), 32, scr, r, F.lane);
    }
}
__device__ __forceinline__ void x_to_bf16(Frame& F, const float* x) {
    const size_t n8 = (size_t)T * DM / 8; hb16* XBp = F.XB();
    for (size_t i = (size_t)blockIdx.x * 512 + F.tid; i < n8; i += (size_t)F.G * 512) {
        const f32x4 a = *(const f32x4*)(x + i * 8), b = *(const f32x4*)(x + i * 8 + 4);
        v4u o; o.x = pk2(a[0], a[1]); o.y = pk2(a[2], a[3]); o.z = pk2(b[0], b[1]); o.w = pk2(b[2], b[3]);
        *(v4u*)(XBp + i * 8) = o; }
}
__device__ __forceinline__ void ln_phase(Frame& F, const float* gam, const float* bet, bool last) {
    const int gw = F.vcu * NWAVES + F.wave, NGW = F.G * NWAVES;
    f32x4 gv[4], bv[4];
#pragma unroll
    for (int j = 0; j < 4; ++j) { gv[j] = *(const f32x4*)(gam + 4 * F.lane + 256 * j); bv[j] = *(const f32x4*)(bet + 4 * F.lane + 256 * j); }
    for (int m = gw; m < T; m += NGW) {
        float* zr = F.out + (size_t)m * DM + 4 * F.lane;
        f32x4 v[4]; float s = 0.f;
#pragma unroll
        for (int j = 0; j < 4; ++j) { v[j] = *(const f32x4*)(zr + 256 * j); s += (v[j][0] + v[j][1]) + (v[j][2] + v[j][3]); }
        const float mean = wave_sum(s) * (1.f / DM); float s2 = 0.f;
#pragma unroll
        for (int j = 0; j < 4; ++j) { v[j] = v[j] - mean; s2 += (v[j][0] * v[j][0] + v[j][1] * v[j][1]) + (v[j][2] * v[j][2] + v[j][3] * v[j][3]); }
        const float rstd = 1.f / sqrtf(wave_sum(s2) * (1.f / DM) + LN_EPS);
        hb16* xr = F.XB() + (size_t)m * DM + 4 * F.lane;
#pragma unroll
        for (int j = 0; j < 4; ++j) { const f32x4 y = v[j] * rstd * gv[j] + bv[j];
            if (last) *(f32x4*)(zr + 256 * j) = y;
            else { v2u o; o.x = pk2(y[0], y[1]); o.y = pk2(y[2], y[3]); *(v2u*)(xr + 256 * j) = o; } }
    }
}
__device__ __forceinline__ float gelu_t(float x) { const float u = 0.7978845608028654f * (x + 0.044715f * x * x * x); return x * __builtin_amdgcn_rcpf(1.f + __builtin_amdgcn_exp2f(-2.f * LOG2E * u)); }
__device__ __forceinline__ void ffn_elem_phase(Frame& F, const float* cw, const float* cbias) {
    const int gw = F.vcu * NWAVES + F.wave, NGW = F.G * NWAVES;
    hb16* BIGp = F.BIG();
    for (int task = gw; task < (T / 16) * 11; task += NGW) {
        const int rc = task / 11, cgp = task % 11, r0 = 16 * rc, c = 256 * cgp + 4 * F.lane;
        const f32x4 w0 = *(const f32x4*)(cw + c), w1 = *(const f32x4*)(cw + DFF + c), w2 = *(const f32x4*)(cw + 2 * DFF + c), b = *(const f32x4*)(cbias + c);
        const bool seq0 = (r0 % SEQ) == 0;
        f32x4 am2 = {0.f, 0.f, 0.f, 0.f}, am1 = {0.f, 0.f, 0.f, 0.f};
        if (!seq0) { const v2u p2 = *(const v2u*)(BIGp + (size_t)(r0 - 2) * FP + c), p1 = *(const v2u*)(BIGp + (size_t)(r0 - 1) * FP + c);
            am2 = (f32x4){bfl(p2.x), bfh(p2.x), bfl(p2.y), bfh(p2.y)}; am1 = (f32x4){bfl(p1.x), bfh(p1.x), bfl(p1.y), bfh(p1.y)}; }
#pragma unroll 4
        for (int i = 0; i < 16; ++i) {
            hb16* rp = BIGp + (size_t)(r0 + i) * FP + c;
            const v2u pa = *(const v2u*)rp, pg = *(const v2u*)(rp + DFF);
            const f32x4 a0 = {bfl(pa.x), bfh(pa.x), bfl(pa.y), bfh(pa.y)}, g = {bfl(pg.x), bfh(pg.x), bfl(pg.y), bfh(pg.y)};
            const f32x4 v = b + w0 * am2 + w1 * am1 + w2 * a0;
            v2u o; o.x = pk2(gelu_t(v[0]) * g[0], gelu_t(v[1]) * g[1]); o.y = pk2(gelu_t(v[2]) * g[2], gelu_t(v[3]) * g[3]);
            *(v2u*)(rp + DFF) = o; am2 = am1; am1 = a0; }
    }
}
__device__ __forceinline__ void cumsum_task(Frame& F, const float* b_forget_l, int bh) {
    const int b = bh >> 3, h = bh & 7; const float bf = b_forget_l[h]; const float* sidep = F.side();
    float v[8]; float s = 0.f;
#pragma unroll
    for (int i = 0; i < 8; ++i) { const int t = 8 * F.tid + i; const float f = sidep[((size_t)b * SEQ + t) * 16 + 4 + h] + bf;
        const float ls = fminf(f, 0.f) - log1pf(__expf(-fabsf(f))); s += ls; v[i] = s; }
    float incl = s;
#pragma unroll
    for (int o = 1; o < 64; o <<= 1) { const float n = __shfl_up(incl, o); if (F.lane >= o) incl += n; }
    LAS float* wt = (LAS float*)F.lds;
    if (F.lane == 63) wt[F.wave] = incl;
    __syncthreads();
    float off = 0.f;
#pragma unroll
    for (int w = 0; w < 8; ++w) { const float x = wt[w]; if (w < F.wave) off += x; }
    const float base = off + incl - s;
    float* o = F.cb() + (size_t)bh * SEQ + 8 * F.tid;
    f32x4 o0, o1;
#pragma unroll
    for (int i = 0; i < 4; ++i) { o0[i] = -(base + v[i]) * LOG2E; o1[i] = -(base + v[4 + i]) * LOG2E; }
    *(f32x4*)o = o0; *(f32x4*)(o + 4) = o1;
    __syncthreads();
}
__device__ __forceinline__ f32x16 band_scores(const hb16* __restrict__ kp, const bf16x8 (&qr)[4], long tok0, int stride, int i0, int j, float slope2, int maxd, int r32, int hi) {
    const int kb = i0 - 128 + 32 * j;
    const hb16* krow = kp + (tok0 + (long)stride * (kb + r32)) * QP + 8 * hi;
    f32x16 acc = {};
#pragma unroll
    for (int s = 0; s < 4; ++s) { const bf16x8 kf = *(const bf16x8*)(krow + 16 * s); acc = __builtin_amdgcn_mfma_f32_32x32x16_bf16(kf, qr[s], acc, 0, 0, 0); }
    const int d0 = 128 - 32 * j + r32 - 4 * hi;
#pragma unroll
    for (int r = 0; r < 16; ++r) { const int dist = d0 - ((r & 3) + 8 * (r >> 2)); const float v = acc[r] - slope2 * (float)dist; acc[r] = (dist >= 0 && dist <= maxd) ? v : -INFINITY; }
    return acc;
}
template <int MODE> __device__ __forceinline__ void banded_unit(
    const hb16* __restrict__ qp, const hb16* __restrict__ kp, const hb16* __restrict__ vp, long tok0, int stride, int i0, float slope2, int maxd, float sink2, bool has_sink,
    hb16* op, hb16* pu, float* pml, const hb16* pu1, const float* pml1, const hb16* pu2, const float* pml2, LAS unsigned char* wl, int lane) {
    const int r32 = lane & 31, hi = lane >> 5;
    const hb16* qrow = qp + (tok0 + (long)stride * (i0 + r32)) * QP;
    bf16x8 qr[4];
#pragma unroll
    for (int s = 0; s < 4; ++s) qr[s] = *(const bf16x8*)(qrow + 16 * s + 8 * hi);
    const int jlo = (i0 >= 128) ? 0 : (128 - i0) / 32;
    float m = -INFINITY;
#pragma unroll 1
    for (int j = jlo; j < 5; ++j) {
        const f32x16 S = band_scores(kp, qr, tok0, stride, i0, j, slope2, maxd, r32, hi);
#pragma unroll
        for (int r = 0; r < 16; ++r) m = fmaxf(m, S[r]);
    }
    m = fmaxf(m, __shfl_xor(m, 32));
    if (has_sink) m = fmaxf(m, sink2);
    float l = 0.f;
    f32x16 o[2]; o[0] = f32x16{}; o[1] = f32x16{};
    const LAS unsigned char* vrd = wl + (4 * hi + ((lane & 15) >> 2)) * 144 + (16 * ((lane >> 4) & 1) + 4 * (lane & 3)) * 2;
#pragma unroll 1
    for (int j = jlo; j < 5; ++j) {
        const int kb = i0 - 128 + 32 * j;
        v4u vx[4];
#pragma unroll
        for (int p = 0; p < 4; ++p) { const int row = (lane >> 3) + 8 * p, piece = lane & 7; vx[p] = *(const v4u*)(vp + (tok0 + (long)stride * (kb + row)) * QP + piece * 8); }
        f32x16 S = band_scores(kp, qr, tok0, stride, i0, j, slope2, maxd, r32, hi);
#pragma unroll
        for (int r = 0; r < 16; ++r) { const float p = __builtin_amdgcn_exp2f(S[r] - m); S[r] = p; l += p; }
#pragma unroll
        for (int p = 0; p < 4; ++p) { const int row = (lane >> 3) + 8 * p, piece = lane & 7; *(LAS v4u*)(wl + row * 144 + piece * 16) = vx[p]; }
        WBAR();
#pragma unroll
        for (int s = 0; s < 2; ++s) {
            v4u pw; pw.x = pk2(S[8 * s + 0], S[8 * s + 1]); pw.y = pk2(S[8 * s + 2], S[8 * s + 3]); pw.z = pk2(S[8 * s + 4], S[8 * s + 5]); pw.w = pk2(S[8 * s + 6], S[8 * s + 7]);
            const bf16x8 pa = __builtin_bit_cast(bf16x8, pw);
#pragma unroll
            for (int db = 0; db < 2; ++db) { const s16x4 lo = vtr(vrd + 16 * s * 144 + db * 64), hh = vtr(vrd + (16 * s + 8) * 144 + db * 64);
                o[db] = __builtin_amdgcn_mfma_f32_32x32x16_bf16(pa, cat8(lo, hh), o[db], 0, 0, 0); }
        }
        WBAR();
        asm volatile("" ::: "memory");
    }
    l += __shfl_xor(l, 32);
    if (has_sink) l += __builtin_amdgcn_exp2f(sink2 - m);
    LAS float* wsf = (LAS float*)(wl + 4608);
    if (MODE == 0) {
        if (hi == 0) wsf[r32] = __builtin_amdgcn_rcpf(l);
        WBAR();
#pragma unroll
        for (int r = 0; r < 16; ++r) { const int q = crow(r, hi); const float inv = wsf[q]; hb16* orow = op + (tok0 + (long)stride * (i0 + q)) * QP;
            orow[r32] = (hb16)f2bf(o[0][r] * inv); orow[32 + r32] = (hb16)f2bf(o[1][r] * inv); }
        WBAR();
    } else if (MODE == 1) {
        if (hi == 0) { float* ml = pml + (tok0 + (long)stride * (i0 + r32)) * 16; ml[0] = m; ml[1] = l; }
#pragma unroll
        for (int r = 0; r < 16; ++r) { const int q = crow(r, hi); hb16* orow = pu + (tok0 + (long)stride * (i0 + q)) * 512;
            orow[r32] = (hb16)f2bf(o[0][r]); orow[32 + r32] = (hb16)f2bf(o[1][r]); }
    } else {
        const long tq = tok0 + (long)stride * (i0 + r32);
        const float m1 = pml1[tq * 16], l1 = pml1[tq * 16 + 1], m2 = pml2[tq * 16], l2 = pml2[tq * 16 + 1];
        const float M = fmaxf(m, fmaxf(m1, m2)); const float f0 = __builtin_amdgcn_exp2f(m - M), f1 = __builtin_amdgcn_exp2f(m1 - M), f2 = __builtin_amdgcn_exp2f(m2 - M);
        const float inv = 1.f / (f0 * l + f1 * l1 + f2 * l2);
        if (hi == 0) { wsf[r32] = f0 * inv; wsf[32 + r32] = f1 * inv; wsf[64 + r32] = f2 * inv; }
        WBAR();
#pragma unroll 4
        for (int r = 0; r < 16; ++r) { const int q = crow(r, hi); const long tk = tok0 + (long)stride * (i0 + q); const float w0 = wsf[q], w1 = wsf[32 + q], w2 = wsf[64 + q];
            const hb16* u1 = pu1 + tk * 512; const hb16* u2 = pu2 + tk * 512; hb16* orow = op + tk * QP;
            orow[r32] = (hb16)f2bf(w0 * o[0][r] + w1 * bf1(u1[r32]) + w2 * bf1(u2[r32]));
            orow[32 + r32] = (hb16)f2bf(w0 * o[1][r] + w1 * bf1(u1[32 + r32]) + w2 * bf1(u2[32 + r32])); }
        WBAR();
    }
}
__device__ __forceinline__ float slope_of(int branch, int h) { return exp2f(-(float)(3 * h + 1 + branch) * (1.f / 3.f)); }

__device__ __forceinline__ float dpp_f(float x, int which) {
    const int v = __float_as_int(x);
    return __int_as_float(which == 0 ? __builtin_amdgcn_mov_dpp(v, 0xB1, 0xF, 0xF, true) : __builtin_amdgcn_mov_dpp(v, 0x4E, 0xF, 0xF, true));
}
__device__ __forceinline__ int wave_isum(int x) {
    x += __builtin_amdgcn_mov_dpp(x, 0xB1, 0xF, 0xF, true);
    x += __builtin_amdgcn_mov_dpp(x, 0x4E, 0xF, 0xF, true);
    x += __builtin_amdgcn_mov_dpp(x, 0x141, 0xF, 0xF, true);
    x += __builtin_amdgcn_mov_dpp(x, 0x140, 0xF, 0xF, true);
    return __builtin_amdgcn_readlane(x, 0) + __builtin_amdgcn_readlane(x, 16) + __builtin_amdgcn_readlane(x, 32) + __builtin_amdgcn_readlane(x, 48);
}
__device__ __forceinline__ int wave_excl_scan(int x, int lane) {
    int incl = x;
#pragma unroll
    for (int o = 1; o < 64; o <<= 1) { const int n = __shfl_up(incl, o); if (lane >= o) incl += n; }
    return incl - x;
}
constexpr int SC_PITCH = 64 * 65 + 4;
__device__ __forceinline__ void indexer_step(Frame& F, int b, int sl) {
    const int lane = F.lane, wave = F.wave, r32 = lane & 31, hi = lane >> 5;
    const int t0 = 8 * sl; const long tokb = (long)b * SEQ;
    const int ntile = (t0 + 8 + 31) >> 5;
    const int qq = r32 >> 2, hh = r32 & 3;
    const hb16* QKV = F.BIG();
    const hb16* iqrow = QKV + (tokb + t0 + qq) * QP + COL_IQ + 64 * hh;
    bf16x8 qf[4];
#pragma unroll
    for (int s = 0; s < 4; ++s) qf[s] = *(const bf16x8*)(iqrow + 16 * s + 8 * hi);
    const float iw = F.side()[(tokb + t0 + qq) * 16 + hh];
    LAS float* sc = (LAS float*)F.lds;
    for (int tile = wave; tile < ntile; tile += 8) {
        const hb16* krow = QKV + (tokb + 32 * tile + r32) * QP + COL_IK;
        f32x16 acc = {};
#pragma unroll
        for (int s = 0; s < 4; ++s) { const bf16x8 kf = *(const bf16x8*)(krow + 16 * s + 8 * hi); acc = __builtin_amdgcn_mfma_f32_32x32x16_bf16(kf, qf[s], acc, 0, 0, 0); }
#pragma unroll
        for (int g4 = 0; g4 < 4; ++g4) { float v[4];
#pragma unroll
            for (int e = 0; e < 4; ++e) { float x = iw * fmaxf(acc[4 * g4 + e], 0.f); x += dpp_f(x, 0); x += dpp_f(x, 1); v[e] = x; }
            float sel = hh == 0 ? v[0] : hh == 1 ? v[1] : hh == 2 ? v[2] : v[3];
            sel = (sel == 0.f) ? 0.f : sel;
            const int kv = 32 * tile + 8 * g4 + 4 * hi + hh;
            sc[qq * SC_PITCH + kv + (kv >> 6)] = sel; }
    }
    __syncthreads();
    {
        const int t = t0 + wave; unsigned short* out = F.idx() + (tokb + t) * 256;
        if (t < 256) {
#pragma unroll
            for (int j = 0; j < 4; ++j) { const int kv = j * 64 + lane; out[kv] = (unsigned short)((kv <= t) ? kv : 0xFFFF); }
        } else {
            const LAS float* s = sc + wave * SC_PITCH + lane * 65;
            unsigned key[64];
#pragma unroll
            for (int j = 0; j < 64; ++j) { const int kv = 64 * lane + j; const unsigned bits = __float_as_uint(s[j]); const unsigned k = bits ^ ((bits >> 31) ? 0xFFFFFFFFu : 0x80000000u); key[j] = (kv <= t) ? k : 0u; }
            unsigned prefix = 0u; bool exact = false;
            for (int bit = 31; bit >= 0; --bit) {
                const unsigned cand = prefix | (1u << bit); int c = 0;
#pragma unroll
                for (int j = 0; j < 64; ++j) c += (key[j] >= cand) ? 1 : 0;
                const int cnt = wave_isum(c);
                if (cnt >= 256) { prefix = cand; if (cnt == 256) { exact = true; break; } }
            }
            int ngt = 0, neq = 0;
#pragma unroll
            for (int j = 0; j < 64; ++j) { ngt += (key[j] > prefix) ? 1 : 0; neq += (key[j] == prefix) ? 1 : 0; }
            const int need = exact ? (1 << 30) : 256 - wave_isum(ngt);
            int eqr = wave_excl_scan(neq, lane);
            const int selc = ngt + max(0, min(neq, need - eqr));
            int pos = wave_excl_scan(selc, lane);
            asm volatile("" : "+v"(prefix));
#pragma unroll
            for (int j = 0; j < 64; ++j) { const bool gt = key[j] > prefix, eq = key[j] == prefix; const bool sel = gt || (eq && eqr < need);
                if (sel && pos < 256) out[pos] = (unsigned short)(64 * lane + j);
                pos += sel ? 1 : 0; eqr += eq ? 1 : 0; }
        }
    }
    __syncthreads();
}
__device__ __forceinline__ void dsa_query(Frame& F, long tokb, int t, LAS unsigned char* wl, int lane) {
    const int c = lane & 15, g = lane >> 4, h = c & 7; const long tok = tokb + t;
    hb16* QKV = F.BIG();
    const hb16* qp = QKV + tok * QP + COL_QC + 64 * h;
    const bf16x8 qf0 = *(const bf16x8*)(qp + 8 * g), qf1 = *(const bf16x8*)(qp + 32 + 8 * g);
    const unsigned short* ix = F.idx() + tok * 256;
    const float slope2 = exp2f(-(float)(h + 1)) * LOG2E;
    f32x4 S[16];
#pragma unroll
    for (int i = 0; i < 16; ++i) {
        unsigned kr = ix[16 * i + c]; if (kr > (unsigned)t) kr = 0u;
        const hb16* kp = QKV + (tokb + kr) * QP + COL_KC;
        const bf16x8 k0 = *(const bf16x8*)(kp + 8 * g), k1 = *(const bf16x8*)(kp + 32 + 8 * g);
        f32x4 acc = {0.f, 0.f, 0.f, 0.f};
        acc = __builtin_amdgcn_mfma_f32_16x16x32_bf16(k0, qf0, acc, 0, 0, 0); acc = __builtin_amdgcn_mfma_f32_16x16x32_bf16(k1, qf1, acc, 0, 0, 0);
        const v2u i4 = *(const v2u*)(ix + 16 * i + 4 * g);
        const int id0 = i4.x & 0xffff, id1 = i4.x >> 16, id2 = i4.y & 0xffff, id3 = i4.y >> 16;
        S[i][0] = (id0 <= t) ? acc[0] - slope2 * (float)(t - id0) : -INFINITY; S[i][1] = (id1 <= t) ? acc[1] - slope2 * (float)(t - id1) : -INFINITY;
        S[i][2] = (id2 <= t) ? acc[2] - slope2 * (float)(t - id2) : -INFINITY; S[i][3] = (id3 <= t) ? acc[3] - slope2 * (float)(t - id3) : -INFINITY;
    }
    float m = -INFINITY;
#pragma unroll
    for (int i = 0; i < 16; ++i) m = fmaxf(m, fmaxf(fmaxf(S[i][0], S[i][1]), fmaxf(S[i][2], S[i][3])));
    m = fmaxf(m, __shfl_xor(m, 16)); m = fmaxf(m, __shfl_xor(m, 32));
    float l = 0.f;
#pragma unroll
    for (int i = 0; i < 16; ++i)
#pragma unroll
        for (int e = 0; e < 4; ++e) { const float p = __builtin_amdgcn_exp2f(S[i][e] - m); S[i][e] = p; l += p; }
    l += __shfl_xor(l, 16); l += __shfl_xor(l, 32);
    f32x4 o[4];
#pragma unroll
    for (int dt = 0; dt < 4; ++dt) o[dt] = (f32x4){0.f, 0.f, 0.f, 0.f};
    const LAS unsigned char* vrd = wl + (4 * g + ((lane & 15) >> 2)) * 144 + 4 * (lane & 3) * 2;
#pragma unroll
    for (int ch = 0; ch < 4; ++ch) {
#pragma unroll
        for (int p = 0; p < 8; ++p) { const int row = (lane >> 3) + 8 * p, piece = lane & 7; unsigned vr = ix[64 * ch + row]; if (vr > (unsigned)t) vr = 0u;
            const v4u x = *(const v4u*)(QKV + (tokb + vr) * QP + COL_VC + piece * 8); *(LAS v4u*)(wl + row * 144 + piece * 16) = x; }
        WBAR();
#pragma unroll
        for (int u2 = 0; u2 < 2; ++u2) { const int u = 2 * ch + u2;
            v4u pw; pw.x = pk2(S[2 * u][0], S[2 * u][1]); pw.y = pk2(S[2 * u][2], S[2 * u][3]); pw.z = pk2(S[2 * u + 1][0], S[2 * u + 1][1]); pw.w = pk2(S[2 * u + 1][2], S[2 * u + 1][3]);
            const bf16x8 pb = __builtin_bit_cast(bf16x8, pw);
#pragma unroll
            for (int dt = 0; dt < 4; ++dt) { const s16x4 lo = vtr(vrd + (32 * u2) * 144 + dt * 32), hh = vtr(vrd + (32 * u2 + 16) * 144 + dt * 32);
                o[dt] = __builtin_amdgcn_mfma_f32_16x16x32_bf16(cat8(lo, hh), pb, o[dt], 0, 0, 0); }
        }
        WBAR();
        asm volatile("" ::: "memory");
    }
    if (c < 8) { const float inv = 1.f / l; hb16* op = QKV + tok * QP + COL_QC + 64 * h + 4 * g;
#pragma unroll
        for (int dt = 0; dt < 4; ++dt) { v2u w; w.x = pk2(o[dt][0] * inv, o[dt][1] * inv); w.y = pk2(o[dt][2] * inv, o[dt][3] * inv); *(v2u*)(op + 16 * dt) = w; } }
}

constexpr int N_PHASES = 1 + 10 * NLAYER;
#ifndef DBG_MASK
#define DBG_MASK 0x7ff
#endif
#ifndef DBG_SUB
#define DBG_SUB 7
#endif
#define DBGK(k) (((DBG_MASK) >> (k)) & 1)
#define DSUB(k) (((DBG_SUB) >> (k)) & 1)

__global__ void __launch_bounds__(NWAVES * 64, 2) mixer_fwd(Args args) {
    extern __shared__ __attribute__((aligned(16))) unsigned char lds[];
    cg::grid_group grid = cg::this_grid();
    const int lo = args.ph_lo, hi = args.ph_hi;
#pragma unroll 1
    for (int ph = lo; ph < hi; ++ph) {
        Frame F;
        { int tid_ = threadIdx.x; asm volatile("" : "+v"(tid_)); F.tid = tid_; }
        F.lds = (LAS unsigned char*)lds; F.lane = F.tid & 63; F.wave = __builtin_amdgcn_readfirstlane(F.tid >> 6);
        F.G = gridDim.x; { const int bx = blockIdx.x; F.vcu = (F.G % 8 == 0) ? (bx % 8) * (F.G / 8) + bx / 8 : bx; }
        F.out = args.out; F.ws = args.ws;
        const int gw = F.vcu * NWAVES + F.wave;
        LAS unsigned char* wl = F.lds + F.wave * 16384;
        const int l = (ph == 0) ? 0 : (ph - 1) / 10, k = (ph == 0) ? 10 : (ph - 1) % 10;
        switch (k) {
        case 10:
            if (DBGK(10)) { convert_weights(F, args, 0); x_to_bf16(F, args.in[0]); }
            break;
        case 0:
            if (DBGK(0)) {
                pg8::Gemm g{F.XB(), F.Win_t(), DM, DM}; pg8::StaticOrder S; S.init(T, QP, F.G, (int)blockIdx.x);
                pg8::EpiBf16 E{F.BIG(), QP, F.side(), 18};
                pg8::gemm_phase<pg8::EpiBf16, pg8::StaticOrder, true>(F.lds, g, S, E);
            }
            break;
        case 1:
            if (DBGK(1)) {
                if (DSUB(0) && blockIdx.x < 32) cumsum_task(F, args.in[2] + l * 8, (int)blockIdx.x);
                if (DSUB(1)) for (int u = gw; u < 4096; u += F.G * NWAVES) {
                    const int h = u & 7, blk = (u >> 3) & 127, b = u >> 10; const long tb = (long)b * SEQ;
                    banded_unit<0>(F.BIG() + COL_QA + 64 * h, F.BIG() + COL_KA + 64 * (h >> 2), F.BIG() + COL_VA + 64 * (h >> 2), tb, 1, 32 * blk, slope_of(0, h) * LOG2E, 127,
                                   args.in[3][l * 8 + h] * LOG2E, true, F.BIG() + COL_QA + 64 * h, nullptr, nullptr, nullptr, nullptr, nullptr, nullptr, wl, F.lane);
                    banded_unit<1>(F.BIG() + COL_QB + 64 * h, F.BIG() + COL_KB + 64 * h, F.BIG() + COL_VB + 64 * h, tb, 1, 32 * blk, slope_of(1, h) * LOG2E, 128, 0.f, false,
                                   nullptr, F.pu1() + 64 * h, F.pml1() + 2 * h, nullptr, nullptr, nullptr, nullptr, wl, F.lane);
                    banded_unit<1>(F.BIG() + COL_QB + 64 * h, F.BIG() + COL_KB + 64 * h, F.BIG() + COL_VB + 64 * h, tb + (blk & 3), 4, 32 * (blk >> 2), slope_of(1, h) * 4.f * LOG2E, 128, 0.f, false,
                                   nullptr, F.pu2() + 64 * h, F.pml2() + 2 * h, nullptr, nullptr, nullptr, nullptr, wl, F.lane);
                }
                __syncthreads();
                if (DSUB(2)) for (int b = 0; b < NB; ++b) { const int c = (int)blockIdx.x; if (c < 256) { indexer_step(F, b, c); indexer_step(F, b, 511 - c); } }
            }
            break;
        case 2:
            if (DBGK(2)) {
                if (DSUB(0)) for (int i = 0; i < 2; ++i) { const int v = F.vcu; if (v < 256) { const int s = v & 7, bh = v >> 3, qb = (i == 0) ? s : 15 - s;
                    fox::attn_unit<8>(bh >> 3, bh & 7, qb, (const fox::bf16*)(F.BIG() + COL_QD), (const fox::bf16*)(F.BIG() + COL_KD), (const fox::bf16*)(F.BIG() + COL_VD), (fox::bf16*)(F.BIG() + COL_QD), F.cb(), (char*)lds); } }
                __syncthreads();
                if (DSUB(1)) for (int q = gw; q < T; q += F.G * NWAVES) dsa_query(F, (long)(q >> 12) * SEQ, q & (SEQ - 1), wl, F.lane);
                if (DSUB(2)) for (int u = gw; u < 4096; u += F.G * NWAVES) {
                    const int h = u & 7, blk = (u >> 3) & 127, b = u >> 10; const long tb = (long)b * SEQ;
                    banded_unit<2>(F.BIG() + COL_QB + 64 * h, F.BIG() + COL_KB + 64 * h, F.BIG() + COL_VB + 64 * h, tb + (blk & 15), 16, 32 * (blk >> 4), slope_of(1, h) * 16.f * LOG2E, 128, 0.f, false,
                                   F.BIG() + COL_QB + 64 * h, nullptr, nullptr, F.pu1() + 64 * h, F.pml1() + 2 * h, F.pu2() + 64 * h, F.pml2() + 2 * h, wl, F.lane);
                }
            }
            break;
        case 3:
            if (DBGK(3)) {
                pg8::StaticOrder S; S.init(T, DM, F.G, (int)blockIdx.x); pg8::FixedUnit FU; FU.have = S.next(0, FU.u0);
                unsigned char* scr = (unsigned char*)F.out + (size_t)blockIdx.x * 131072;
#pragma unroll 1
                for (int n = 0; n < 4; ++n) {
                    { pg8::Gemm g{F.XB(), F.Wg_t() + (size_t)n * 1024 * DM, DM, DM}; pg8::EpiGate E{scr, args.in[6] + (size_t)l * 4096 + n * 1024};
                      pg8::gemm_phase<pg8::EpiGate, pg8::FixedUnit, false>(F.lds, g, FU, E); }
                    { pg8::Gemm g{F.BIG() + 512 * n, F.Wb_t() + (size_t)n * 1024 * 512, QP, 512}; pg8::EpiProj E{scr, F.BIG() + COL_MRG, QP, n == 0};
                      pg8::gemm_phase<pg8::EpiProj, pg8::FixedUnit, false>(F.lds, g, FU, E); }
                }
            }
            break;
        case 4:
            if (DBGK(4)) {
                pg8::Gemm g{F.BIG() + COL_MRG, F.Wo_t(), QP, DM}; pg8::StaticOrder S; S.init(T, DM, F.G, (int)blockIdx.x);
                pg8::EpiResF32 E{F.XB(), DM, F.out, DM, ALPHA};
                pg8::gemm_phase<pg8::EpiResF32, pg8::StaticOrder, false>(F.lds, g, S, E);
            }
            break;
        case 5:
            if (DBGK(5)) ln_phase(F, args.in[8] + (size_t)l * DM, args.in[9] + (size_t)l * DM, false);
            break;
        case 6:
            if (DBGK(6)) {
                pg8::Gemm g{F.XB(), F.Wuf_t(), DM, DM}; pg8::StaticOrder S; S.init(T, FP, F.G, (int)blockIdx.x);
                pg8::EpiBf16 E{F.BIG(), FP, nullptr, -1};
                pg8::gemm_phase<pg8::EpiBf16, pg8::StaticOrder, true>(F.lds, g, S, E);
            }
            break;
        case 7:
            if (DBGK(7)) ffn_elem_phase(F, args.in[12] + (size_t)l * 3 * DFF, args.in[13] + (size_t)l * DFF);
            break;
        case 8:
            if (DBGK(8)) {
                pg8::Gemm g{F.BIG() + DFF, F.Wd_t(), FP, DFF}; pg8::StaticOrder S; S.init(T, DM, F.G, (int)blockIdx.x);
                pg8::EpiResF32 E{F.XB(), DM, F.out, DM, ALPHA};
                pg8::gemm_phase<pg8::EpiResF32, pg8::StaticOrder, false>(F.lds, g, S, E);
            }
            break;
        default:
            if (DBGK(9)) {
                ln_phase(F, args.in[15] + (size_t)l * DM, args.in[16] + (size_t)l * DM, l == NLAYER - 1);
                if (l + 1 < NLAYER) convert_weights(F, args, l + 1);
            }
            break;
        }
        if (ph + 1 < hi) grid.sync();
    }
}

#ifndef MK_ONE_LAUNCH
#define MK_ONE_LAUNCH 1
#endif
extern "C" void kernel_launch(void* const* d_in, const int* in_sizes, int n_in, void* d_out, int out_size, void* d_ws, size_t ws_size, hipStream_t stream) {
    static int grid = 0;
    if (grid == 0) {
        if (n_in != 17 || out_size != T * DM || ws_size < WS_END) { fprintf(stderr, "kernel_launch: unexpected shapes (n_in %d out %d ws %zu)\n", n_in, out_size, ws_size); grid = -1; return; }
        int dev = 0, cus = 0, per_cu = 0;
        if (hipGetDevice(&dev) != hipSuccess || hipDeviceGetAttribute(&cus, hipDeviceAttributeMultiprocessorCount, dev) != hipSuccess) { grid = -1; return; }
        if (hipFuncSetAttribute((const void*)mixer_fwd, hipFuncAttributeMaxDynamicSharedMemorySize, LDS_BYTES) != hipSuccess) { fprintf(stderr, "kernel_launch: hipFuncSetAttribute failed\n"); grid = -1; return; }
        if (hipOccupancyMaxActiveBlocksPerMultiprocessor(&per_cu, (const void*)mixer_fwd, NWAVES * 64, LDS_BYTES) != hipSuccess || per_cu < 1) { fprintf(stderr, "kernel_launch: occupancy query says %d\n", per_cu); per_cu = 1; }
        (void)hipGetLastError();
        grid = cus;
        if (grid != 256) fprintf(stderr, "kernel_launch: %d CUs (built for 256)\n", grid);
    }
    if (grid < 0) return;
    Args a{};
    for (int i = 0; i < 17; ++i) a.in[i] = (const float*)d_in[i];
    a.out = (float*)d_out; a.ws = (unsigned char*)d_ws;
#if MK_ONE_LAUNCH
    a.ph_lo = 0; a.ph_hi = N_PHASES;
    void* kargs[] = {&a};
    hipError_t e = hipLaunchCooperativeKernel((const void*)mixer_fwd, dim3(grid), dim3(NWAVES * 64), kargs, LDS_BYTES, stream);
    if (e != hipSuccess) fprintf(stderr, "kernel_launch: cooperative launch failed: %s\n", hipGetErrorString(e));
#else
    for (int p = 0; p < N_PHASES; ++p) {
        a.ph_lo = p; a.ph_hi = p + 1;
        hipLaunchKernelGGL(mixer_fwd, dim3(grid), dim3(NWAVES * 64), LDS_BYTES, stream, a);
    }
#endif
}
```

```cpp
#include <hip/hip_runtime.h>
#include <hip/hip_cooperative_groups.h>
#include <hip/hip_bf16.h>
#include <cstdio>
#include <cstdint>
#include <cmath>
namespace cg = cooperative_groups;

namespace pg8 {
#define PG8_LAS __attribute__((address_space(3)))
typedef unsigned short bf16_t;
typedef short bf16x8 __attribute__((ext_vector_type(8)));
typedef float f32x4 __attribute__((ext_vector_type(4)));
typedef float f32x2 __attribute__((ext_vector_type(2)));
typedef unsigned u32x4 __attribute__((ext_vector_type(4)));
typedef unsigned u32x2 __attribute__((ext_vector_type(2)));
constexpr int BM = 256, BK = 64, HALF = 128, HTB = HALF * BK * 2, STAGE_BYTES = 8 * HTB, NXCD = 8, WGM = 8;

__host__ __device__ __forceinline__ int lds_byte(int r, int c) { const int st = (r >> 4) * 2 + (c >> 5), rr = r & 15, cc = c & 31, ob = rr * 64 + cc * 2; return st * 1024 + (ob ^ (((ob >> 9) & 1) << 5)); }
__host__ __device__ __forceinline__ void stage_rc(int b, int& R, int& C) { const int st = b / 1024, sb = b % 1024, swz = sb ^ (((sb >> 9) & 1) << 5); R = (st >> 1) * 16 + swz / 64; C = (st & 1) * 32 + (swz % 64) / 2; }
__host__ __device__ __forceinline__ int perm32(int rho) { const int n = rho >> 4, i = rho & 15; return 8 * (i >> 2) + 4 * n + (i & 3); }

struct Unit { int pm, pn; };
struct Gemm { const bf16_t* A; const bf16_t* Bt; int lda, K; };

struct StaticOrder {
    int nM, nN, nwg, G, c;
    __host__ __device__ void init(int M, int N, int G_, int c_) { nM = M / BM; nN = N / BM; nwg = nM * nN; G = G_; c = c_; }
    __host__ __device__ bool next(int i, Unit& u) const {
        const long L = (long)i * G + c; if (L >= nwg) return false;
        int wgid = (int)L; { const int q = nwg / NXCD, r = nwg % NXCD, xcd = wgid % NXCD, off = wgid / NXCD; wgid = (xcd < r ? xcd * (q + 1) : r * (q + 1) + (xcd - r) * q) + off; }
        const int nig = WGM * nN, gid = wgid / nig, fm = gid * WGM, gsz = (nM - fm) < WGM ? (nM - fm) : WGM;
        u.pm = fm + ((wgid % nig) % gsz); u.pn = (wgid % nig) / gsz; return true;
    }
};
struct FixedUnit {
    Unit u0; bool have;
    __host__ __device__ bool next(int i, Unit& u) const { if (i != 0 || !have) return false; u = u0; return true; }
};

__device__ __forceinline__ unsigned cvt_pk_bf16(float lo, float hi) { unsigned r; asm volatile("v_cvt_pk_bf16_f32 %0, %1, %2" : "=v"(r) : "v"(lo), "v"(hi)); return r; }
__device__ __forceinline__ float bf_lo(unsigned w) { return __uint_as_float(w << 16); }
__device__ __forceinline__ float bf_hi(unsigned w) { return __uint_as_float(w & 0xffff0000u); }

struct EpiBf16 {
    static constexpr bool PERM = true;
    bf16_t* O; int ldc; float* side; int side_pn;
    __device__ __forceinline__ void operator()(const f32x4 (&acc)[2][2][4][2], const Unit& u, int wr, int wc, int fr, int fq) const {
        const int row0 = u.pm * BM + wr * 64 + fr; const int col0 = u.pn * BM + wc * 32 + 8 * fq;
        const bool sd = (side != nullptr) && (u.pn == side_pn) && (wc == 2) && (fq < 2);
#pragma unroll
        for (int ai = 0; ai < 2; ++ai)
#pragma unroll
            for (int m = 0; m < 4; ++m) { const int row = row0 + ai * HALF + m * 16; bf16_t* rowp = O + (size_t)row * ldc + col0;
#pragma unroll
                for (int bj = 0; bj < 2; ++bj) { const f32x4 v0 = acc[ai][bj][m][0], v1 = acc[ai][bj][m][1];
                    u32x4 w; w.x = cvt_pk_bf16(v0[0], v0[1]); w.y = cvt_pk_bf16(v0[2], v0[3]); w.z = cvt_pk_bf16(v1[0], v1[1]); w.w = cvt_pk_bf16(v1[2], v1[3]);
                    *(u32x4*)(rowp + bj * HALF) = w;
                    if (bj == 1 && sd) { float* sp = side + (size_t)row * 16 + 8 * fq; *(f32x4*)sp = v0; if (fq == 0) *(f32x4*)(sp + 4) = v1; } } }
    }
};
__device__ __forceinline__ u32x4* scr_slot(unsigned char* base, int k, int tid) { return (u32x4*)(base + (size_t)(k * 512 + tid) * 16); }
struct EpiGate {
    static constexpr bool PERM = true;
    unsigned char* scr; const float* bias;
    __device__ __forceinline__ void operator()(const f32x4 (&acc)[2][2][4][2], const Unit& u, int wr, int wc, int fr, int fq) const {
        int tid = threadIdx.x; asm volatile("" : "+v"(tid));
        const int col0 = u.pn * BM + wc * 32 + 8 * fq;
        f32x4 bv[2][2];
#pragma unroll
        for (int bj = 0; bj < 2; ++bj)
#pragma unroll
            for (int n = 0; n < 2; ++n) bv[bj][n] = *(const f32x4*)(bias + col0 + bj * HALF + 4 * n);
#pragma unroll
        for (int ai = 0; ai < 2; ++ai)
#pragma unroll
            for (int m = 0; m < 4; ++m)
#pragma unroll
                for (int bj = 0; bj < 2; ++bj) { f32x4 v0 = acc[ai][bj][m][0] + bv[bj][0], v1 = acc[ai][bj][m][1] + bv[bj][1];
#pragma unroll
                    for (int e = 0; e < 4; ++e) { v0[e] = __builtin_amdgcn_rcpf(1.f + __builtin_amdgcn_exp2f(-1.4426950408889634f * v0[e])); v1[e] = __builtin_amdgcn_rcpf(1.f + __builtin_amdgcn_exp2f(-1.4426950408889634f * v1[e])); }
                    u32x4 w; w.x = cvt_pk_bf16(v0[0], v0[1]); w.y = cvt_pk_bf16(v0[2], v0[3]); w.z = cvt_pk_bf16(v1[0], v1[1]); w.w = cvt_pk_bf16(v1[2], v1[3]);
                    *scr_slot(scr, (ai * 4 + m) * 2 + bj, tid) = w; asm volatile("" ::: "memory"); }
    }
};
struct EpiProj {
    static constexpr bool PERM = true;
    unsigned char* scr; bf16_t* Mg; int ldc; int first;
    __device__ __forceinline__ void operator()(const f32x4 (&acc)[2][2][4][2], const Unit& u, int wr, int wc, int fr, int fq) const {
        int tid = threadIdx.x; int row0 = u.pm * BM + wr * 64 + fr; asm volatile("" : "+v"(tid), "+v"(row0)); const int col0 = u.pn * BM + wc * 32 + 8 * fq;
#pragma unroll
        for (int ai = 0; ai < 2; ++ai)
#pragma unroll
            for (int m = 0; m < 4; ++m) { bf16_t* rowp = Mg + (size_t)(row0 + ai * HALF + m * 16) * ldc + col0;
#pragma unroll
                for (int bj = 0; bj < 2; ++bj) { const u32x4 gw = *scr_slot(scr, (ai * 4 + m) * 2 + bj, tid);
                    f32x4 v0 = acc[ai][bj][m][0], v1 = acc[ai][bj][m][1];
                    v0[0] *= bf_lo(gw.x); v0[1] *= bf_hi(gw.x); v0[2] *= bf_lo(gw.y); v0[3] *= bf_hi(gw.y); v1[0] *= bf_lo(gw.z); v1[1] *= bf_hi(gw.z); v1[2] *= bf_lo(gw.w); v1[3] *= bf_hi(gw.w);
                    if (!first) { const u32x4 ow = *(const u32x4*)(rowp + bj * HALF);
                        v0[0] += bf_lo(ow.x); v0[1] += bf_hi(ow.x); v0[2] += bf_lo(ow.y); v0[3] += bf_hi(ow.y); v1[0] += bf_lo(ow.z); v1[1] += bf_hi(ow.z); v1[2] += bf_lo(ow.w); v1[3] += bf_hi(ow.w); }
                    u32x4 w; w.x = cvt_pk_bf16(v0[0], v0[1]); w.y = cvt_pk_bf16(v0[2], v0[3]); w.z = cvt_pk_bf16(v1[0], v1[1]); w.w = cvt_pk_bf16(v1[2], v1[3]);
                    *(u32x4*)(rowp + bj * HALF) = w; asm volatile("" ::: "memory"); } }
    }
};
struct EpiResF32 {
    static constexpr bool PERM = false;
    const bf16_t* res; int ldr; float* out; int ldc; float alpha;
    __device__ __forceinline__ void operator()(const f32x4 (&acc)[2][2][4][2], const Unit& u, int wr, int wc, int fr, int fq) const {
        const int row0 = u.pm * BM + wr * 64 + fr; const int col0 = u.pn * BM + wc * 32 + 4 * fq;
#pragma unroll
        for (int ai = 0; ai < 2; ++ai)
#pragma unroll
            for (int m = 0; m < 4; ++m) { const int row = row0 + ai * HALF + m * 16;
#pragma unroll
                for (int bj = 0; bj < 2; ++bj)
#pragma unroll
                    for (int n = 0; n < 2; ++n) { const int c = col0 + bj * HALF + n * 16; const u32x2 rw = *(const u32x2*)(res + (size_t)row * ldr + c);
                        f32x4 o = acc[ai][bj][m][n]; o[0] += alpha * bf_lo(rw.x); o[1] += alpha * bf_hi(rw.x); o[2] += alpha * bf_lo(rw.y); o[3] += alpha * bf_hi(rw.y);
                        *(f32x4*)(out + (size_t)row * ldc + c) = o; } }
    }
};

template <class Epi, class Sched, bool ALIGN_EPI>
__device__ __forceinline__ void gemm_phase(PG8_LAS unsigned char* lds, const Gemm g, const Sched& S, const Epi& E) {
    int tid_ = threadIdx.x; asm volatile("" : "+v"(tid_));
    const int tid = tid_, wid = __builtin_amdgcn_readfirstlane(tid >> 6), lane = tid & 63, wr = wid >> 2, wc = wid & 3, fr = lane & 15, fq = lane >> 4;
    const int K = g.K, nt = K / BK, lda = g.lda;
    unsigned voffA[2], voffB[2];
#pragma unroll
    for (int i = 0; i < 2; ++i) { int R, C; stage_rc(tid * 16 + i * 8192, R, C); const int Rb = Epi::PERM ? ((R & ~31) + perm32(R & 31)) : R;
        voffA[i] = (unsigned)(R * lda + C) * 2u; voffB[i] = (unsigned)(Rb * K + C) * 2u; }
    const size_t kstep = (size_t)(BK * 2);
    const size_t hstepA = (size_t)HALF * lda * 2, hstepB = (size_t)HALF * K * 2;
    const size_t tstepA = 2 * hstepA, tstepB = 2 * hstepB;
    const unsigned ldsw = (unsigned)wid * 1024u;
    const int aoff = lds_byte(wr * 64 + fr, fq * 8), boff = lds_byte(wc * 32 + fr, fq * 8);
#define PG8_SA(b, h) (((b) * 2 + (h)) * HTB)
#define PG8_SB(b, h) ((4 + (b) * 2 + (h)) * HTB)
#define PG8_STAGE(bufoff, gbase, voff) do { _Pragma("unroll") for (int _i = 0; _i < 2; ++_i) \
        __builtin_amdgcn_global_load_lds((const unsigned*)((const char*)(gbase) + (voff)[_i]), (PG8_LAS unsigned*)(lds + (bufoff) + ldsw + _i * 8192), 16, 0, 0); } while (0)
#define PG8_LDA(dst, b, h) do { _Pragma("unroll") for (int m = 0; m < 4; ++m) _Pragma("unroll") for (int k = 0; k < 2; ++k) dst[m][k] = *(const PG8_LAS bf16x8*)(lds + PG8_SA(b, h) + aoff + m * 2048 + k * 1024); } while (0)
#define PG8_LDB(dst, b, h) do { _Pragma("unroll") for (int n = 0; n < 2; ++n) _Pragma("unroll") for (int k = 0; k < 2; ++k) dst[n][k] = *(const PG8_LAS bf16x8*)(lds + PG8_SB(b, h) + boff + n * 2048 + k * 1024); } while (0)
#define PG8_MMA(ai, bj, At, Bt) do { __builtin_amdgcn_s_setprio(1); _Pragma("unroll") for (int m = 0; m < 4; ++m) _Pragma("unroll") for (int n = 0; n < 2; ++n) _Pragma("unroll") for (int k = 0; k < 2; ++k) \
        acc[ai][bj][m][n] = __builtin_amdgcn_mfma_f32_16x16x32_bf16(Bt[n][k], At[m][k], acc[ai][bj][m][n], 0, 0, 0); __builtin_amdgcn_s_setprio(0); } while (0)
#define PG8_WAIT_V(n) asm volatile("s_waitcnt vmcnt(" #n ")" ::: "memory")
#define PG8_WAIT_L(n) asm volatile("s_waitcnt lgkmcnt(" #n ")" ::: "memory")
#define PG8_BAR __builtin_amdgcn_s_barrier()
#define PG8_SCHED __builtin_amdgcn_sched_barrier(0)
    Unit cur, nxt; int ui = 0;
    if (!S.next(0, cur)) return;
    f32x4 acc[2][2][4][2];
#pragma unroll
    for (int a = 0; a < 2; ++a)
#pragma unroll
        for (int b = 0; b < 2; ++b)
#pragma unroll
            for (int m = 0; m < 4; ++m)
#pragma unroll
                for (int n = 0; n < 2; ++n) acc[a][b][m][n] = (f32x4){0.f, 0.f, 0.f, 0.f};
    bf16x8 At[4][2], B0[2][2], B1[2][2];
    const char* cA = (const char*)g.A + (size_t)cur.pm * tstepA; const char* cB = (const char*)g.Bt + (size_t)cur.pn * tstepB;
    PG8_STAGE(PG8_SB(0, 0), cB, voffB); PG8_STAGE(PG8_SB(0, 1), cB + hstepB, voffB); PG8_STAGE(PG8_SA(0, 0), cA, voffA); PG8_STAGE(PG8_SA(0, 1), cA + hstepA, voffA);
    if (wr == 1) PG8_BAR;
    PG8_WAIT_V(2); PG8_BAR;
    PG8_STAGE(PG8_SB(1, 0), cB + kstep, voffB); PG8_STAGE(PG8_SA(1, 0), cA + kstep, voffA); PG8_STAGE(PG8_SB(1, 1), cB + hstepB + kstep, voffB);
    PG8_WAIT_V(6); PG8_BAR;
    for (;;) {
        const bool has_next = S.next(ui + 1, nxt);
        const char* nA = has_next ? (const char*)g.A + (size_t)nxt.pm * tstepA : cA; const char* nB = has_next ? (const char*)g.Bt + (size_t)nxt.pn * tstepB : cB;
        for (int t = 0; t < nt; t += 2) {
            const bool last = (t == nt - 2);
            const char* a1 = cA + (size_t)(t + 1) * kstep;
            const char* a2 = last ? nA : cA + (size_t)(t + 2) * kstep; const char* b2 = last ? nB : cB + (size_t)(t + 2) * kstep;
            const char* a3 = a2 + kstep; const char* b3 = b2 + kstep;
            PG8_LDB(B0, 0, 0); PG8_LDB(B1, 0, 1); PG8_SCHED; PG8_LDA(At, 0, 0); PG8_STAGE(PG8_SA(1, 1), a1 + hstepA, voffA);
            PG8_WAIT_V(8); PG8_WAIT_L(0); PG8_BAR; PG8_MMA(0, 0, At, B0); PG8_MMA(0, 1, At, B1); PG8_BAR; PG8_SCHED;
            PG8_LDA(At, 0, 1); PG8_STAGE(PG8_SB(0, 0), b2, voffB); PG8_STAGE(PG8_SB(0, 1), b2 + hstepB, voffB); PG8_STAGE(PG8_SA(0, 0), a2, voffA);
            PG8_WAIT_V(8); PG8_WAIT_L(0); PG8_BAR; PG8_MMA(1, 0, At, B0); PG8_MMA(1, 1, At, B1); PG8_BAR; PG8_SCHED;
            PG8_LDB(B0, 1, 0); PG8_LDB(B1, 1, 1); PG8_SCHED; PG8_LDA(At, 1, 0); PG8_STAGE(PG8_SA(0, 1), a2 + hstepA, voffA);
            PG8_WAIT_V(8); PG8_WAIT_L(0); PG8_BAR; PG8_MMA(0, 0, At, B0); PG8_MMA(0, 1, At, B1); PG8_BAR; PG8_SCHED;
            PG8_LDA(At, 1, 1); PG8_STAGE(PG8_SB(1, 0), b3, voffB); PG8_STAGE(PG8_SB(1, 1), b3 + hstepB, voffB); PG8_STAGE(PG8_SA(1, 0), a3, voffA);
            PG8_WAIT_V(8); PG8_WAIT_L(0); PG8_BAR; PG8_MMA(1, 0, At, B0); PG8_MMA(1, 1, At, B1); PG8_BAR; PG8_SCHED;
        }
        if constexpr (ALIGN_EPI) { if (wr == 0) PG8_BAR; }
        E(acc, cur, wr, wc, fr, fq);
        if (!has_next) break;
#pragma unroll
        for (int a = 0; a < 2; ++a)
#pragma unroll
            for (int b = 0; b < 2; ++b)
#pragma unroll
                for (int m = 0; m < 4; ++m)
#pragma unroll
                    for (int n = 0; n < 2; ++n) acc[a][b][m][n] = (f32x4){0.f, 0.f, 0.f, 0.f};
        cur = nxt; cA = nA; cB = nB; ++ui;
        if constexpr (ALIGN_EPI) { if (wr == 1) PG8_BAR; }
    }
    PG8_WAIT_V(0);
    if constexpr (!ALIGN_EPI) { if (wr == 0) PG8_BAR; }
    PG8_BAR;
#undef PG8_SA
#undef PG8_SB
#undef PG8_STAGE
#undef PG8_LDA
#undef PG8_LDB
#undef PG8_MMA
#undef PG8_WAIT_V
#undef PG8_WAIT_L
#undef PG8_BAR
#undef PG8_SCHED
}
}
namespace fox {
using bf16=__hip_bfloat16;
using bf16x8=__attribute__((ext_vector_type(8)))short;
using s16x4=__attribute__((ext_vector_type(4)))short;
using f32x16=__attribute__((ext_vector_type(16)))float;
using u32x4=__attribute__((ext_vector_type(4)))unsigned;
constexpr int BATCH=4,NHEAD=8,SEQ=4096,D=64,DM=4864;
constexpr int NW=8,QBLK=32,QB=QBLK*NW,KVBLK=64,NQB=SEQ/QB;
constexpr int ATTN_PITCH=DM, ATTN_UNIT_ROWS=QB;
__device__ __forceinline__ int crow(int r,int hi){return (r&3)+8*(r>>2)+4*hi;}
#define SBAR() __builtin_amdgcn_sched_barrier(0)
__device__ __forceinline__ void cmask(f32x16&p0,f32x16&p1,int jb,int qrel,int hi){
  const float NEG=-INFINITY; int kb=64*jb+4*hi;
  #pragma unroll
  for(int r=0;r<16;++r){int kv=kb+(r&3)+8*(r>>2); if(kv>qrel)p0[r]=NEG; if(kv+32>qrel)p1[r]=NEG;}
}

constexpr int NSLOT=3, SLOTB=8192;
constexpr int LDS_K=0, LDS_V=NSLOT*SLOTB, LDS_WS=2*NSLOT*SLOTB, LDS_OST=LDS_WS+NW*64*4, LDS_BIAS=LDS_OST+NW*4096, LDS_BYTES=LDS_BIAS+SEQ*4;
constexpr float C2=0.125f*1.4426950408889634f;
__device__ __forceinline__ void glds16(const void*gsrc,unsigned lds_dst){unsigned keep;
  asm volatile("s_mov_b32 %0, m0\n\ts_mov_b32 m0, %2\n\ts_nop 0\n\tglobal_load_lds_dwordx4 %1, off\n\ts_mov_b32 m0, %0":"=&s"(keep):"v"(gsrc),"s"(lds_dst):"memory");}
__device__ __forceinline__ float max3f(float a,float b,float c){float r;asm("v_max3_f32 %0, %1, %2, %3":"=v"(r):"v"(a),"v"(b),"v"(c));return r;}
__device__ __forceinline__ float max2f(float a,float b){float r;asm("v_max_f32_e32 %0, %1, %2":"=v"(r):"v"(a),"v"(b));return r;}
__device__ __forceinline__ float fadd_s(float a,float b){float r;asm("v_add_f32_e32 %0, %1, %2":"=v"(r):"v"(a),"v"(b));return r;}
__device__ __forceinline__ float fsub_s(float a,float b){float r;asm("v_sub_f32_e32 %0, %1, %2":"=v"(r):"v"(a),"v"(b));return r;}
typedef float f32x2_t __attribute__((ext_vector_type(2))); typedef __bf16 bf16x2_t __attribute__((ext_vector_type(2)));
__device__ __forceinline__ unsigned cvtpk_s(float lo,float hi){f32x2_t v={lo,hi};bf16x2_t b=__builtin_convertvector(v,bf16x2_t);return __builtin_bit_cast(unsigned,b);}
#define WAIT_BAR(N) asm volatile("s_waitcnt vmcnt(" #N ") lgkmcnt(0)\n\ts_barrier":::"memory")

__device__ __forceinline__ void qkt(f32x16&p0,f32x16&p1,const char*Kslot,const bf16x8*qr,int r32,int hi){
  const char*kb=Kslot+hi*1024+r32*16;
  #pragma unroll
  for(int d0=0;d0<4;++d0){
    const bf16x8 b0=*reinterpret_cast<const bf16x8*>(kb+d0*2048);
    const bf16x8 b1=*reinterpret_cast<const bf16x8*>(kb+d0*2048+512);
    p0=__builtin_amdgcn_mfma_f32_32x32x16_bf16(b0,qr[d0],p0,0,0,0);p1=__builtin_amdgcn_mfma_f32_32x32x16_bf16(b1,qr[d0],p1,0,0,0);}
}
typedef __attribute__((address_space(3))) const char* lds_cptr;
typedef short v4i16_t __attribute__((ext_vector_type(4)));
__device__ __forceinline__ void kload8(bf16x8*kf,lds_cptr kp){
  kf[0]=*(const __attribute__((address_space(3))) bf16x8*)(kp);      kf[1]=*(const __attribute__((address_space(3))) bf16x8*)(kp+512);
  kf[2]=*(const __attribute__((address_space(3))) bf16x8*)(kp+2048); kf[3]=*(const __attribute__((address_space(3))) bf16x8*)(kp+2560);
  kf[4]=*(const __attribute__((address_space(3))) bf16x8*)(kp+4096); kf[5]=*(const __attribute__((address_space(3))) bf16x8*)(kp+4608);
  kf[6]=*(const __attribute__((address_space(3))) bf16x8*)(kp+6144); kf[7]=*(const __attribute__((address_space(3))) bf16x8*)(kp+6656);
}
__device__ __forceinline__ void kload2(bf16x8*kf,lds_cptr kp,int j){ kf[2*j]=*(const __attribute__((address_space(3))) bf16x8*)(kp+j*2048); kf[2*j+1]=*(const __attribute__((address_space(3))) bf16x8*)(kp+j*2048+512); }
__device__ __forceinline__ s16x4 vtr(lds_cptr p){ return __builtin_bit_cast(s16x4,__builtin_amdgcn_ds_read_tr16_b64_v4i16((__attribute__((address_space(3))) v4i16_t*)p)); }
__device__ __forceinline__ float rowmax(const f32x16&p0,const f32x16&p1){
  float a=max3f(p0[0],p0[1],p1[0]),b=max3f(p0[2],p0[3],p1[1]);a=max3f(a,p1[2],p1[3]);
  #pragma unroll
  for(int r=4;r<16;r+=4){a=max3f(a,p0[r],p0[r+1]);b=max3f(b,p0[r+2],p0[r+3]);a=max3f(a,p1[r],p1[r+1]);b=max3f(b,p1[r+2],p1[r+3]);}
  const float m=max2f(a,b);
  auto rr=__builtin_amdgcn_permlane32_swap(__float_as_uint(m),__float_as_uint(m),false,false);
  return max2f(__uint_as_float(rr[0]),__uint_as_float(rr[1]));
}
__device__ __forceinline__ void pv(f32x16*o,int vb,bf16x8 pa0,bf16x8 pa1,bf16x8 pa2,bf16x8 pa3){
  #pragma unroll
  for(int d0=0;d0<2;++d0){s16x4 lo[4],hi[4];
    #pragma unroll
    for(int ks=0;ks<4;++ks){
      asm volatile("ds_read_b64_tr_b16 %0,%1 offset:%c2":"=&v"(lo[ks]):"v"(vb),"i"(d0*4096+ks*1024):"memory");
      asm volatile("ds_read_b64_tr_b16 %0,%1 offset:%c2":"=&v"(hi[ks]):"v"(vb),"i"(d0*4096+ks*1024+512):"memory");}
    asm volatile("s_waitcnt lgkmcnt(0)":::"memory");SBAR();
    #define PK(k) (bf16x8){lo[k][0],lo[k][1],lo[k][2],lo[k][3],hi[k][0],hi[k][1],hi[k][2],hi[k][3]}
    o[d0]=__builtin_amdgcn_mfma_f32_32x32x16_bf16(pa0,PK(0),o[d0],0,0,0);
    o[d0]=__builtin_amdgcn_mfma_f32_32x32x16_bf16(pa1,PK(1),o[d0],0,0,0);
    o[d0]=__builtin_amdgcn_mfma_f32_32x32x16_bf16(pa2,PK(2),o[d0],0,0,0);
    o[d0]=__builtin_amdgcn_mfma_f32_32x32x16_bf16(pa3,PK(3),o[d0],0,0,0);
    #undef PK
  }
}

#ifndef ATTN_STORE16
#define ATTN_STORE16(p,v) (*(u32x4*)(p)=(v))
#endif
template<int THRL> __device__ __forceinline__ void attn_unit(int b,int h,int qb,const bf16*Q,const bf16*__restrict__ K,const bf16*__restrict__ V,bf16*O,const float*__restrict__ cbias,bool store_en,char*shm){
  int tid_=threadIdx.x; asm volatile("":"+v"(tid_));
  const int tid=tid_,lane=tid&63,r32=lane&31,hi=lane>>5; const int wid=__builtin_amdgcn_readfirstlane(tid>>6);
  const long rowbase=(long)b*SEQ; const int q0=qb*QB;
  const bf16*Qw=Q+(rowbase+q0+wid*QBLK)*DM+h*D;
  const bf16*Kh=K+rowbase*DM+h*D,*Vh=V+rowbase*DM+h*D;
  const unsigned lds0=(unsigned)(uintptr_t)shm;
  float*wsf=(float*)(shm+LDS_WS)+wid*64;
  const bf16*ksrc=Kh+(long)lane*DM+wid*8;
  const bf16*vsrc=Vh+(long)(16*(wid&3)+(lane>>2))*DM+(wid>>2)*32+(lane&3)*8;
  const unsigned kdst=lds0+LDS_K+wid*1024, vdst=lds0+LDS_V+wid*1024;
  #define DMA_K(t,slot) glds16(ksrc+(long)(t)*KVBLK*DM,(unsigned)__builtin_amdgcn_readfirstlane(kdst+(slot)))
  #define DMA_V(t,slot) glds16(vsrc+(long)(t)*KVBLK*DM,(unsigned)__builtin_amdgcn_readfirstlane(vdst+(slot)))
  const int vb0=(int)(lds0+LDS_V)+((lane>>4)&1)*32+(lane&3)*8+(4*hi+((lane&15)>>2))*64;
  const char*Kbase=shm+LDS_K; bf16x8 kf[8];
  const lds_cptr shm3=(lds_cptr)shm; const lds_cptr kp0=shm3+LDS_K+hi*1024+r32*16; const lds_cptr vp0=shm3+LDS_V+((lane>>4)&1)*32+(lane&3)*8+(4*hi+((lane&15)>>2))*64;
  const int NT=(q0+QB)/KVBLK;
  typedef float f32x4v __attribute__((ext_vector_type(4)));
  __attribute__((address_space(3))) float* const blds=(__attribute__((address_space(3))) float*)((__attribute__((address_space(3))) char*)shm+LDS_BIAS);
  { const float* cb=cbias+((long)b*NHEAD+h)*SEQ; const int nk=q0+QB;
    for(int i=tid*4;i<nk;i+=2048){ const f32x4v v=*(const f32x4v*)(cb+i); *(__attribute__((address_space(3))) f32x4v*)(blds+i)=v; } }
  #define BINIT(C0,C1,t) do{ const __attribute__((address_space(3))) float* bp_=blds+64*(t)+4*hi; \
     _Pragma("unroll") for(int g_=0;g_<4;++g_){ const f32x4v b0_=*(const __attribute__((address_space(3))) f32x4v*)(bp_+8*g_); const f32x4v b1_=*(const __attribute__((address_space(3))) f32x4v*)(bp_+32+8*g_); \
       _Pragma("unroll") for(int i_=0;i_<4;++i_){ C0[4*g_+i_]=b0_[i_]-mhat; C1[4*g_+i_]=b1_[i_]-mhat; } } }while(0)
  DMA_K(0,0);DMA_V(0,0);DMA_K(1,SLOTB);
  bf16x8 qr[4];
  #pragma unroll
  for(int d0=0;d0<4;++d0)qr[d0]=*reinterpret_cast<const bf16x8*>(&Qw[(long)r32*DM+d0*16+hi*8]);
  float mhat=0.f,l_reg=0.f;f32x16 o[2];o[0]=f32x16{};o[1]=f32x16{};
  const int qrel=wid*QBLK+r32;
  #define CMASK(P0,P1,t) do{int jb_=(t)-(NT-4); if(jb_>=0)cmask(P0,P1,jb_,qrel,hi);}while(0)
  bool resc=false;
  #define START(P0,P1) do{ const float rm=rowmax(P0,P1); resc=false; \
    { const float dl=rm; mhat=fadd_s(mhat,dl); \
      _Pragma("unroll") for(int r=0;r<16;++r){P0[r]=fsub_s(P0[r],dl);P1[r]=fsub_s(P1[r],dl);} \
      } \
    _Pragma("unroll") for(int r=0;r<16;++r)P0[r]=__builtin_amdgcn_exp2f(P0[r]); }while(0)
  #define RESC() do{ if(resc){ asm volatile("s_waitcnt lgkmcnt(0)":::"memory"); \
      _Pragma("unroll") for(int d_=0;d_<2;++d_) _Pragma("unroll") for(int r=0;r<16;++r)o[d_][r]*=wsf[crow(r,hi)]; } }while(0)
  f32x16 pA0,pA1,pB0,pB1;
  int sl_prev=0,sl_cur=0,sl_next=SLOTB;
  #define ROT() do{sl_prev=sl_cur;sl_cur=sl_next;sl_next=(sl_next==(NSLOT-1)*SLOTB)?0:sl_next+SLOTB;}while(0)
  DMA_K(2,2*SLOTB);
  WAIT_BAR(3);
  BINIT(pA0,pA1,0); qkt(pA0,pA1,Kbase,qr,r32,hi);asm volatile("s_nop 15\n\ts_nop 7":"+v"(pA0),"+v"(pA1));CMASK(pA0,pA1,0);
  START(pA0,pA1);
  _Pragma("unroll") for(int r=0;r<16;++r)pA1[r]=__builtin_amdgcn_exp2f(pA1[r]);
  WAIT_BAR(0);
  DMA_K(3,0);DMA_V(1,SLOTB);
  ROT();
  kload8(kf,kp0+sl_cur);
  WAIT_BAR(2);
  s16x4 vlo[8],vhi[8]; u32x4 pw0,pw1,pw2,pw3;
  #define PKW(P,B) cvtpk_s(P[B],P[B+1])
  #define PAF(k) __builtin_bit_cast(bf16x8,pw##k)
  #define VFR(i) (bf16x8){vlo[i][0],vlo[i][1],vlo[i][2],vlo[i][3],vhi[i][0],vhi[i][1],vhi[i][2],vhi[i][3]}
  #define PIN(x) asm volatile("":"+v"(x))
  #define MX3(a,b,c) __builtin_fmaxf(__builtin_fmaxf((a),(b)),(c))
  #define GAPA(MF,A0,A1,A2,A3,W0,W1,PW) do{ MF; sacc+=A0; sacc+=A1; sacc+=A2; sacc+=A3; PIN(sacc); W0; W1; PIN(PW); SBAR(); }while(0)
  #define EX(v) __builtin_amdgcn_exp2f(v)
  #define GAPB(MF,X,B) do{ MF; X[B]=EX(X[B]); X[B+1]=EX(X[B+1]); X[B+2]=EX(X[B+2]); X[B+3]=EX(X[B+3]); PIN(X); SBAR(); }while(0)
  #define VRD(i) do{ vlo[i]=vtr(vp_+(((i)>>2)*4096+((i)&3)*1024)); vhi[i]=vtr(vp_+(((i)>>2)*4096+((i)&3)*1024+512)); }while(0)
  #define KRD(G,j) do{ if(G){ kload2(kf,kp0+sl_next,j); SBAR(); } }while(0)
  #define STEP(C0,C1,P0,P1,t,GK,GV,GL) do{ SBAR(); BINIT(C0,C1,t); SBAR(); \
    const lds_cptr vp_=vp0+sl_prev; \
    VRD(0); SBAR(); float sacc=(P0[0]+P0[1]); \
    GAPA(C0=__builtin_amdgcn_mfma_f32_32x32x16_bf16(kf[0],qr[0],C0,0,0,0), P0[2],P0[3],P0[4],P0[5],     pw0[0]=PKW(P0,0), pw0[1]=PKW(P0,2), pw0); \
    VRD(4); SBAR(); GAPA(C1=__builtin_amdgcn_mfma_f32_32x32x16_bf16(kf[1],qr[0],C1,0,0,0), P0[6],P0[7],P0[8],P0[9],     pw0[2]=PKW(P0,4), pw0[3]=PKW(P0,6), pw0); \
    VRD(1); SBAR(); GAPA(C0=__builtin_amdgcn_mfma_f32_32x32x16_bf16(kf[2],qr[1],C0,0,0,0),   P0[10],P0[11],P0[12],P0[13], pw1[0]=PKW(P0,8), pw1[1]=PKW(P0,10), pw1); \
    VRD(5); SBAR(); GAPA(C1=__builtin_amdgcn_mfma_f32_32x32x16_bf16(kf[3],qr[1],C1,0,0,0),   P0[14],P0[15],P1[0],P1[1],   pw1[2]=PKW(P0,12),pw1[3]=PKW(P0,14), pw1); \
    VRD(2); SBAR(); GAPA(C0=__builtin_amdgcn_mfma_f32_32x32x16_bf16(kf[4],qr[2],C0,0,0,0),   P1[2],P1[3],P1[4],P1[5],     pw2[0]=PKW(P1,0), pw2[1]=PKW(P1,2), pw2); \
    VRD(6); SBAR(); GAPA(C1=__builtin_amdgcn_mfma_f32_32x32x16_bf16(kf[5],qr[2],C1,0,0,0),   P1[6],P1[7],P1[8],P1[9],     pw2[2]=PKW(P1,4), pw2[3]=PKW(P1,6), pw2); \
    VRD(3); SBAR(); GAPA(C0=__builtin_amdgcn_mfma_f32_32x32x16_bf16(kf[6],qr[3],C0,0,0,0),   P1[10],P1[11],P1[12],P1[13], pw3[0]=PKW(P1,8), pw3[1]=PKW(P1,10), pw3); \
    VRD(7); SBAR(); GAPA(C1=__builtin_amdgcn_mfma_f32_32x32x16_bf16(kf[7],qr[3],C1,0,0,0),   P1[14],P1[15],0.f,0.f,       pw3[2]=PKW(P1,12),pw3[3]=PKW(P1,14), pw3); \
    l_reg+=sacc; \
    if(GK){DMA_K((t)+3,sl_cur);} if(GV){DMA_V((t)+1,sl_next);} \
    CMASK(C0,C1,t); \
    { float a=MX3(C0[0],C0[1],C1[0]),b=MX3(C0[2],C0[3],C1[1]); a=MX3(a,C1[2],C1[3]); \
      _Pragma("unroll") for(int r=4;r<16;r+=4){a=MX3(a,C0[r],C0[r+1]);b=MX3(b,C0[r+2],C0[r+3]);a=MX3(a,C1[r],C1[r+1]);b=MX3(b,C1[r+2],C1[r+3]);} \
      float rm=__builtin_fmaxf(a,b); { auto rr=__builtin_amdgcn_permlane32_swap(__float_as_uint(rm),__float_as_uint(rm),false,false); rm=__builtin_fmaxf(__uint_as_float(rr[0]),__uint_as_float(rr[1])); } \
      resc=false; \
      if(__builtin_expect(__any(rm>(float)THRL),0)){ const float dl=__builtin_fmaxf(rm,0.f); mhat+=dl; \
        _Pragma("unroll") for(int r=0;r<16;++r){C0[r]-=dl;C1[r]-=dl;} \
        const float f=__builtin_amdgcn_exp2f(-dl); l_reg*=f; if(hi==0)wsf[r32]=f; resc=true; } } \
    SBAR(); \
    GAPB(o[0]=__builtin_amdgcn_mfma_f32_32x32x16_bf16(PAF(0),VFR(0),o[0],0,0,0), C0,0); \
    GAPB(o[1]=__builtin_amdgcn_mfma_f32_32x32x16_bf16(PAF(0),VFR(4),o[1],0,0,0), C0,4); \
    KRD(GL,0); GAPB(o[0]=__builtin_amdgcn_mfma_f32_32x32x16_bf16(PAF(1),VFR(1),o[0],0,0,0), C0,8); \
    KRD(GL,1); GAPB(o[1]=__builtin_amdgcn_mfma_f32_32x32x16_bf16(PAF(1),VFR(5),o[1],0,0,0), C0,12); \
    KRD(GL,2); GAPB(o[0]=__builtin_amdgcn_mfma_f32_32x32x16_bf16(PAF(2),VFR(2),o[0],0,0,0), C1,0); \
    KRD(GL,3); GAPB(o[1]=__builtin_amdgcn_mfma_f32_32x32x16_bf16(PAF(2),VFR(6),o[1],0,0,0), C1,4); \
    GAPB(o[0]=__builtin_amdgcn_mfma_f32_32x32x16_bf16(PAF(3),VFR(3),o[0],0,0,0), C1,8); \
    GAPB(o[1]=__builtin_amdgcn_mfma_f32_32x32x16_bf16(PAF(3),VFR(7),o[1],0,0,0), C1,12); \
    }while(0)
  int t=1;
  #undef CMASK
  #define CMASK(P0,P1,t) do{}while(0)
  for(;t+5<NT;t+=2){
    STEP(pB0,pB1,pA0,pA1,t,true,true,true);     WAIT_BAR(2); RESC(); ROT();
    STEP(pA0,pA1,pB0,pB1,t+1,true,true,true);   WAIT_BAR(2); RESC(); ROT();
  }
  #undef CMASK
  #define CMASK(P0,P1,t) do{int jb_=(t)-(NT-4); if(jb_>=0)cmask(P0,P1,jb_,qrel,hi);}while(0)
  #define ENDW(tt) do{ if((tt)+3<NT){WAIT_BAR(2);} else if((tt)+2<NT){WAIT_BAR(1);} else {WAIT_BAR(0);} }while(0)
  for(;t+1<NT;t+=2){
    STEP(pB0,pB1,pA0,pA1,t,(t+3<NT),(t+1<NT),(t+1<NT));       ENDW(t);   RESC(); ROT();
    STEP(pA0,pA1,pB0,pB1,t+1,(t+4<NT),(t+2<NT),(t+2<NT));     ENDW(t+1); RESC(); ROT();
  }
  STEP(pB0,pB1,pA0,pA1,NT-1,false,false,false); RESC();
  { float sacc=pB0[0]+pB0[1]; _Pragma("unroll") for(int r=2;r<16;++r)sacc+=pB0[r]; _Pragma("unroll") for(int r=0;r<16;++r)sacc+=pB1[r]; l_reg+=sacc;
    pw0=(u32x4){PKW(pB0,0),PKW(pB0,2),PKW(pB0,4),PKW(pB0,6)};pw1=(u32x4){PKW(pB0,8),PKW(pB0,10),PKW(pB0,12),PKW(pB0,14)};pw2=(u32x4){PKW(pB1,0),PKW(pB1,2),PKW(pB1,4),PKW(pB1,6)};pw3=(u32x4){PKW(pB1,8),PKW(pB1,10),PKW(pB1,12),PKW(pB1,14)};
    SBAR(); pv(o,vb0+sl_cur,PAF(0),PAF(1),PAF(2),PAF(3)); }
  #undef PKW
  #undef PAF
  #undef VFR
  #undef PIN
  #undef MX3
  #undef GAPA
  #undef GAPB
  #undef EX
  #undef VRD
  #undef KRD
  #undef STEP
  #undef ENDW
  {auto rr=__builtin_amdgcn_permlane32_swap(__float_as_uint(l_reg),__float_as_uint(l_reg),false,false);l_reg=__uint_as_float(rr[0])+__uint_as_float(rr[1]);}
  if(hi==0)wsf[32+r32]=l_reg;asm volatile("s_waitcnt lgkmcnt(0)":::"memory");
  float rli[16];
  #pragma unroll
  for(int r=0;r<16;++r)rli[r]=__builtin_amdgcn_rcpf(wsf[32+crow(r,hi)]);
  bf16*Ow=O+(rowbase+q0+wid*QBLK)*DM+h*D;
  { bf16*stg=(bf16*)(shm+LDS_OST)+wid*2048;
    #pragma unroll
    for(int r=0;r<16;++r){const int orow=crow(r,hi);
      #pragma unroll
      for(int d0=0;d0<2;++d0)stg[orow*64+d0*32+r32]=__float2bfloat16(o[d0][r]*rli[r]);}
    asm volatile("s_waitcnt lgkmcnt(0)":::"memory");
    #pragma unroll
    for(int i=0;i<4;++i){const int row=i*8+(lane>>3),ch=lane&7; const u32x4 v=*(const u32x4*)(stg+row*64+ch*8); if(store_en)ATTN_STORE16(Ow+(long)row*DM+ch*8,v);} }
  asm volatile("s_waitcnt lgkmcnt(0)\n\ts_barrier":::"memory");
  #undef DMA_K
  #undef DMA_V
  #undef BINIT
  #undef CMASK
  #undef START
  #undef RESC
  #undef ROT
}
constexpr int ATTN_LDS_BYTES=LDS_BYTES;
#undef SBAR
#undef WAIT_BAR
}
#define LAS __attribute__((address_space(3)))
typedef unsigned short hb16;
typedef unsigned v4u __attribute__((ext_vector_type(4)));
typedef unsigned v2u __attribute__((ext_vector_type(2)));
typedef float f32x4 __attribute__((ext_vector_type(4)));
typedef float f32x16 __attribute__((ext_vector_type(16)));
typedef short bf16x8 __attribute__((ext_vector_type(8)));
typedef short s16x4 __attribute__((ext_vector_type(4)));

constexpr int NB = 4, SEQ = 4096, T = NB * SEQ, DM = 1024, DFF = 2816, QP = 4864, FP = 5632, NLAYER = 2;
constexpr float LOG2E = 1.4426950408889634f;
constexpr float C2 = 0.125f * LOG2E;
constexpr float ALPHA = 1.4142135623730951f;
constexpr float LN_EPS = 1e-5f;
constexpr int COL_QA = 0, COL_QB = 512, COL_QC = 1024, COL_QD = 1536, COL_KA = 2048, COL_VA = 2176, COL_KB = 2304, COL_VB = 2816, COL_KC = 3328, COL_VC = 3392,
              COL_IQ = 3456, COL_IK = 3712, COL_KD = 3776, COL_VD = 4288, COL_IW = 4800, COL_DF = 4804;
constexpr int COL_GSCR = 2048, COL_MRG = 3072;
constexpr size_t MiB = 1u << 20;
constexpr size_t WS_CTL = 0, CTL_ZERO_BYTES = 16384;
constexpr size_t WS_W = 1 * MiB;
constexpr size_t W_IN = 0, W_G = W_IN + (size_t)QP * DM * 2, W_B = W_G + (size_t)4096 * DM * 2, W_O = W_B + (size_t)4 * 1024 * 512 * 2, W_UF = W_O + (size_t)DM * DM * 2, W_D = W_UF + (size_t)FP * DM * 2, W_END = W_D + (size_t)DM * DFF * 2;
static_assert(W_END == 40 * MiB, "weights");
constexpr size_t WS_XB = 41 * MiB, WS_BIG = 73 * MiB, WS_SIDE = 249 * MiB, WS_CB = 250 * MiB, WS_END = 256 * MiB;
static_assert(WS_BIG + (size_t)T * FP * 2 <= WS_SIDE && WS_BIG + (size_t)T * QP * 2 <= WS_SIDE, "big");
constexpr size_t DO_IDX = 0, DO_PU1 = 8 * MiB, DO_PU2 = 24 * MiB, DO_PML1 = 40 * MiB, DO_PML2 = 41 * MiB;
constexpr int LDS_BYTES = 147456;
constexpr int NWAVES = 8;

struct Args { const float* in[17]; float* out; unsigned char* ws; int ph_lo, ph_hi; };
static_assert(sizeof(Args) == 17 * 8 + 8 + 8 + 8, "Args has no padding");
struct Frame {
    LAS unsigned char* lds; int tid, lane, wave, vcu, G;
    float* out; unsigned char* ws;
    __device__ __forceinline__ hb16* Win_t() const { return (hb16*)(ws + WS_W + W_IN); }
    __device__ __forceinline__ hb16* Wg_t() const { return (hb16*)(ws + WS_W + W_G); }
    __device__ __forceinline__ hb16* Wb_t() const { return (hb16*)(ws + WS_W + W_B); }
    __device__ __forceinline__ hb16* Wo_t() const { return (hb16*)(ws + WS_W + W_O); }
    __device__ __forceinline__ hb16* Wuf_t() const { return (hb16*)(ws + WS_W + W_UF); }
    __device__ __forceinline__ hb16* Wd_t() const { return (hb16*)(ws + WS_W + W_D); }
    __device__ __forceinline__ hb16* XB() const { return (hb16*)(ws + WS_XB); }
    __device__ __forceinline__ hb16* BIG() const { return (hb16*)(ws + WS_BIG); }
    __device__ __forceinline__ float* side() const { return (float*)(ws + WS_SIDE); }
    __device__ __forceinline__ float* cb() const { return (float*)(ws + WS_CB); }
    __device__ __forceinline__ unsigned short* idx() const { return (unsigned short*)((unsigned char*)out + DO_IDX); }
    __device__ __forceinline__ hb16* pu1() const { return (hb16*)((unsigned char*)out + DO_PU1); }
    __device__ __forceinline__ hb16* pu2() const { return (hb16*)((unsigned char*)out + DO_PU2); }
    __device__ __forceinline__ float* pml1() const { return (float*)((unsigned char*)out + DO_PML1); }
    __device__ __forceinline__ float* pml2() const { return (float*)((unsigned char*)out + DO_PML2); }
};

__device__ __forceinline__ unsigned f2bf(float f) { unsigned u = __builtin_bit_cast(unsigned, f); return (u + 0x7fffu + ((u >> 16) & 1u)) >> 16; }
__device__ __forceinline__ unsigned pk2(float lo, float hi) { return f2bf(lo) | (f2bf(hi) << 16); }
__device__ __forceinline__ float bfl(unsigned w) { return __uint_as_float(w << 16); }
__device__ __forceinline__ float bfh(unsigned w) { return __uint_as_float(w & 0xffff0000u); }
__device__ __forceinline__ float bf1(hb16 w) { return __uint_as_float((unsigned)w << 16); }
__device__ __forceinline__ float wave_sum(float v) {
#pragma unroll
    for (int o = 1; o < 64; o <<= 1) v += __shfl_xor(v, o);
    return v;
}
__device__ __forceinline__ int crow(int r, int hi) { return (r & 3) + 8 * (r >> 2) + 4 * hi; }
#define LDS_WAIT() asm volatile("s_waitcnt lgkmcnt(0)" ::: "memory")
#define WBAR() __builtin_amdgcn_wave_barrier()
__device__ __forceinline__ s16x4 vtr(const LAS unsigned char* p) { typedef short v4i16_t __attribute__((ext_vector_type(4))); return __builtin_bit_cast(s16x4, __builtin_amdgcn_ds_read_tr16_b64_v4i16((LAS v4i16_t*)p)); }
__device__ __forceinline__ bf16x8 cat8(s16x4 lo, s16x4 hi) { return (bf16x8){lo[0], lo[1], lo[2], lo[3], hi[0], hi[1], hi[2], hi[3]}; }

__device__ __forceinline__ void tr_item(const float* W, int srcN, int K, hb16* WT, int nblk, LAS float* scr, int item, int lane) {
    const int kb = item / nblk, nb = item % nblk, k0 = 64 * kb, n0 = 32 * nb;
#pragma unroll 8
    for (int i = 0; i < 32; ++i) { const int kk = 2 * i + (lane >> 5); scr[kk * 33 + (lane & 31)] = W[(size_t)(k0 + kk) * srcN + n0 + (lane & 31)]; }
    LDS_WAIT(); asm volatile("" ::: "memory");
    const int c = lane & 7;
#pragma unroll
    for (int j = 0; j < 4; ++j) { const int n = (lane >> 3) + 8 * j; const LAS float* s = scr + (8 * c) * 33 + n;
        v4u o; o.x = pk2(s[0 * 33], s[1 * 33]); o.y = pk2(s[2 * 33], s[3 * 33]); o.z = pk2(s[4 * 33], s[5 * 33]); o.w = pk2(s[6 * 33], s[7 * 33]);
        *(v4u*)(WT + (size_t)(n0 + n) * K + k0 + 8 * c) = o; }
    LDS_WAIT(); asm volatile("" ::: "memory");
}
__device__ __forceinline__ int win_src(int n, float& sc) {
    sc = 1.f;
    if (n < 2048) { sc = C2; const int br = n >> 9, o = n & 511; return (br == 0 ? 0 : br == 1 ? 768 : br == 2 ? 2304 : 3268) + o; }
    if (n < 2176) return 512 + (n - 2048);
    if (n < 2304) return 640 + (n - 2176);
    if (n < 2816) return 1280 + (n - 2304);
    if (n < 3328) return 1792 + (n - 2816);
    if (n < 3392) return 2816 + (n - 3328);
    if (n < 3456) return 2880 + (n - 3392);
    if (n < 3712) { sc = 0.125f; return 2944 + (n - 3456); }
    if (n < 3776) return 3200 + (n - 3712);
    if (n < 4288) return 3780 + (n - 3776);
    if (n < 4800) return 4292 + (n - 4288);
    if (n < 4804) return 3264 + (n - 4800);
    if (n < 4812) return 4804 + (n - 4804);
    sc = 0.f; return 0;
}
__device__ __forceinline__ void tr_item_win(const float* W, hb16* WT, LAS float* scr, int item, int lane) {
    constexpr int nblk = QP / 32, K = DM, srcN = 4812;
    const int kb = item / nblk, nb = item % nblk, k0 = 64 * kb, n0 = 32 * nb;
    float sc; const int sn = win_src(n0 + (lane & 31), sc);
#pragma unroll 8
    for (int i = 0; i < 32; ++i) { const int kk = 2 * i + (lane >> 5); scr[kk * 33 + (lane & 31)] = W[(size_t)(k0 + kk) * srcN + sn] * sc; }
    LDS_WAIT(); asm volatile("" ::: "memory");
    const int c = lane & 7;
#pragma unroll
    for (int j = 0; j < 4; ++j) { const int n = (lane >> 3) + 8 * j; const LAS float* s = scr + (8 * c) * 33 + n;
        v4u o; o.x = pk2(s[0 * 33], s[1 * 33]); o.y = pk2(s[2 * 33], s[3 * 33]); o.z = pk2(s[4 * 33], s[5 * 33]); o.w = pk2(s[6 * 33], s[7 * 33]);
        *(v4u*)(WT + (size_t)(n0 + n) * K + k0 + 8 * c) = o; }
    LDS_WAIT(); asm volatile("" ::: "memory");
}
__device__ __forceinline__ void convert_weights(Frame& F, const Args& A, int l) {
    LAS float* scr = (LAS float*)(F.lds + F.wave * 16384);
    const int gw = F.vcu * NWAVES + F.wave, NGW = F.G * NWAVES;
    constexpr int I_IN = 16 * (QP / 32), I_G = 16 * 128, I_B1 = 8 * 32, I_O = 16 * 32, I_U = 16 * 88, I_D = 44 * 32;
    constexpr int NITEMS = I_IN + I_G + 4 * I_B1 + I_O + 2 * I_U + I_D;
    const float* w_in = A.in[1] + (size_t)l * DM * 4812; const float* w_br = A.in[4] + (size_t)l * 4 * 512 * DM; const float* w_g = A.in[5] + (size_t)l * DM * 4096;
    const float* w_o = A.in[7] + (size_t)l * DM * DM; const float* w_up = A.in[10] + (size_t)l * DM * DFF; const float* w_fg = A.in[11] + (size_t)l * DM * DFF; const float* w_dn = A.in[14] + (size_t)l * DFF * DM;
    for (int it = gw; it < NITEMS; it += NGW) {
        int r = it;
        if (r < I_IN) { tr_item_win(w_in, F.Win_t(), scr, r, F.lane); continue; } r -= I_IN;
        if (r < I_G) { tr_item(w_g, 4096, DM, F.Wg_t(), 128, scr, r, F.lane); continue; } r -= I_G;
        if (r < 4 * I_B1) { const int n = r / I_B1; tr_item(w_br + (size_t)n * 512 * DM, DM, 512, F.Wb_t() + (size_t)n * 1024 * 512, 32, scr, r % I_B1, F.lane); continue; } r -= 4 * I_B1;
        if (r < I_O) { tr_item(w_o, DM, DM, F.Wo_t(), 32, scr, r, F.lane); continue; } r -= I_O;
        if (r < I_U) { tr_item(w_up, DFF, DM, F.Wuf_t(), 88, scr, r, F.lane); continue; } r -= I_U;
        if (r < I_U) { tr_item(w_fg, DFF, DM, F.Wuf_t() + (size_t)DFF * DM, 88, scr, r, F.lane); continue; } r -= I_U;
        tr_item(w_dn, DM, DFF, F.Wd_t(), 32, scr, r, F.lane);
    }
}
__device__ __forceinline__ void x_to_bf16(Frame& F, const float* x) {
    const size_t n8 = (size_t)T * DM / 8; hb16* XBp = F.XB();
    for (size_t i = (size_t)blockIdx.x * 512 + F.tid; i < n8; i += (size_t)F.G * 512) {
        const f32x4 a = *(const f32x4*)(x + i * 8), b = *(const f32x4*)(x + i * 8 + 4);
        v4u o; o.x = pk2(a[0], a[1]); o.y = pk2(a[2], a[3]); o.z = pk2(b[0], b[1]); o.w = pk2(b[2], b[3]);
        *(v4u*)(XBp + i * 8) = o; }
}
__device__ __forceinline__ void ln_phase(Frame& F, const float* gam, const float* bet, bool last) {
    const int gw = F.vcu * NWAVES + F.wave, NGW = F.G * NWAVES;
    f32x4 gv[4], bv[4];
#pragma unroll
    for (int j = 0; j < 4; ++j) { gv[j] = *(const f32x4*)(gam + 4 * F.lane + 256 * j); bv[j] = *(const f32x4*)(bet + 4 * F.lane + 256 * j); }
    for (int m = gw; m < T; m += NGW) {
        float* zr = F.out + (size_t)m * DM + 4 * F.lane;
        f32x4 v[4]; float s = 0.f;
#pragma unroll
        for (int j = 0; j < 4; ++j) { v[j] = *(const f32x4*)(zr + 256 * j); s += (v[j][0] + v[j][1]) + (v[j][2] + v[j][3]); }
        const float mean = wave_sum(s) * (1.f / DM); float s2 = 0.f;
#pragma unroll
        for (int j = 0; j < 4; ++j) { v[j] = v[j] - mean; s2 += (v[j][0] * v[j][0] + v[j][1] * v[j][1]) + (v[j][2] * v[j][2] + v[j][3] * v[j][3]); }
        const float rstd = 1.f / sqrtf(wave_sum(s2) * (1.f / DM) + LN_EPS);
        hb16* xr = F.XB() + (size_t)m * DM + 4 * F.lane;
#pragma unroll
        for (int j = 0; j < 4; ++j) { const f32x4 y = v[j] * rstd * gv[j] + bv[j];
            if (last) *(f32x4*)(zr + 256 * j) = y;
            else { v2u o; o.x = pk2(y[0], y[1]); o.y = pk2(y[2], y[3]); *(v2u*)(xr + 256 * j) = o; } }
    }
}
__device__ __forceinline__ float gelu_t(float x) { const float u = 0.7978845608028654f * (x + 0.044715f * x * x * x); return x * __builtin_amdgcn_rcpf(1.f + __builtin_amdgcn_exp2f(-2.f * LOG2E * u)); }
__device__ __forceinline__ void ffn_elem_phase(Frame& F, const float* cw, const float* cbias) {
    const int gw = F.vcu * NWAVES + F.wave, NGW = F.G * NWAVES;
    hb16* BIGp = F.BIG();
    for (int task = gw; task < (T / 16) * 11; task += NGW) {
        const int rc = task / 11, cgp = task % 11, r0 = 16 * rc, c = 256 * cgp + 4 * F.lane;
        const f32x4 w0 = *(const f32x4*)(cw + c), w1 = *(const f32x4*)(cw + DFF + c), w2 = *(const f32x4*)(cw + 2 * DFF + c), b = *(const f32x4*)(cbias + c);
        const bool seq0 = (r0 % SEQ) == 0;
        f32x4 am2 = {0.f, 0.f, 0.f, 0.f}, am1 = {0.f, 0.f, 0.f, 0.f};
        if (!seq0) { const v2u p2 = *(const v2u*)(BIGp + (size_t)(r0 - 2) * FP + c), p1 = *(const v2u*)(BIGp + (size_t)(r0 - 1) * FP + c);
            am2 = (f32x4){bfl(p2.x), bfh(p2.x), bfl(p2.y), bfh(p2.y)}; am1 = (f32x4){bfl(p1.x), bfh(p1.x), bfl(p1.y), bfh(p1.y)}; }
#pragma unroll 4
        for (int i = 0; i < 16; ++i) {
            hb16* rp = BIGp + (size_t)(r0 + i) * FP + c;
            const v2u pa = *(const v2u*)rp, pg = *(const v2u*)(rp + DFF);
            const f32x4 a0 = {bfl(pa.x), bfh(pa.x), bfl(pa.y), bfh(pa.y)}, g = {bfl(pg.x), bfh(pg.x), bfl(pg.y), bfh(pg.y)};
            const f32x4 v = b + w0 * am2 + w1 * am1 + w2 * a0;
            v2u o; o.x = pk2(gelu_t(v[0]) * g[0], gelu_t(v[1]) * g[1]); o.y = pk2(gelu_t(v[2]) * g[2], gelu_t(v[3]) * g[3]);
            *(v2u*)(rp + DFF) = o; am2 = am1; am1 = a0; }
    }
}
__device__ __forceinline__ void cumsum_task(Frame& F, const float* b_forget_l, int bh) {
    const int b = bh >> 3, h = bh & 7; const float bf = b_forget_l[h]; const float* sidep = F.side();
    float v[8]; float s = 0.f;
#pragma unroll
    for (int i = 0; i < 8; ++i) { const int t = 8 * F.tid + i; const float f = sidep[((size_t)b * SEQ + t) * 16 + 4 + h] + bf;
        const float ls = fminf(f, 0.f) - log1pf(__expf(-fabsf(f))); s += ls; v[i] = s; }
    float incl = s;
#pragma unroll
    for (int o = 1; o < 64; o <<= 1) { const float n = __shfl_up(incl, o); if (F.lane >= o) incl += n; }
    LAS float* wt = (LAS float*)F.lds;
    if (F.lane == 63) wt[F.wave] = incl;
    __syncthreads();
    float off = 0.f;
#pragma unroll
    for (int w = 0; w < 8; ++w) { const float x = wt[w]; if (w < F.wave) off += x; }
    const float base = off + incl - s;
    float* o = F.cb() + (size_t)bh * SEQ + 8 * F.tid;
    f32x4 o0, o1;
#pragma unroll
    for (int i = 0; i < 4; ++i) { o0[i] = -(base + v[i]) * LOG2E; o1[i] = -(base + v[4 + i]) * LOG2E; }
    *(f32x4*)o = o0; *(f32x4*)(o + 4) = o1;
    __syncthreads();
}
__device__ __forceinline__ f32x16 band_scores(const hb16* __restrict__ kp, const bf16x8 (&qr)[4], long tok0, int stride, int i0, int j, float slope2, int maxd, int r32, int hi) {
    const int kb = i0 - 128 + 32 * j;
    const hb16* krow = kp + (tok0 + (long)stride * (kb + r32)) * QP + 8 * hi;
    f32x16 acc = {};
#pragma unroll
    for (int s = 0; s < 4; ++s) { const bf16x8 kf = *(const bf16x8*)(krow + 16 * s); acc = __builtin_amdgcn_mfma_f32_32x32x16_bf16(kf, qr[s], acc, 0, 0, 0); }
    const int d0 = 128 - 32 * j + r32 - 4 * hi;
#pragma unroll
    for (int r = 0; r < 16; ++r) { const int dist = d0 - ((r & 3) + 8 * (r >> 2)); const float v = acc[r] - slope2 * (float)dist; acc[r] = (dist >= 0 && dist <= maxd) ? v : -INFINITY; }
    return acc;
}
template <int MODE> __device__ __forceinline__ void banded_unit(
    const hb16* __restrict__ qp, const hb16* __restrict__ kp, const hb16* __restrict__ vp, long tok0, int stride, int i0, float slope2, int maxd, float sink2, bool has_sink,
    hb16* op, hb16* pu, float* pml, const hb16* pu1, const float* pml1, const hb16* pu2, const float* pml2, LAS unsigned char* wl, int lane) {
    const int r32 = lane & 31, hi = lane >> 5;
    const hb16* qrow = qp + (tok0 + (long)stride * (i0 + r32)) * QP;
    bf16x8 qr[4];
#pragma unroll
    for (int s = 0; s < 4; ++s) qr[s] = *(const bf16x8*)(qrow + 16 * s + 8 * hi);
    const int jlo = (i0 >= 128) ? 0 : (128 - i0) / 32;
    float m = -INFINITY;
#pragma unroll 1
    for (int j = jlo; j < 5; ++j) {
        const f32x16 S = band_scores(kp, qr, tok0, stride, i0, j, slope2, maxd, r32, hi);
#pragma unroll
        for (int r = 0; r < 16; ++r) m = fmaxf(m, S[r]);
    }
    m = fmaxf(m, __shfl_xor(m, 32));
    if (has_sink) m = fmaxf(m, sink2);
    float l = 0.f;
    f32x16 o[2]; o[0] = f32x16{}; o[1] = f32x16{};
    const LAS unsigned char* vrd = wl + (4 * hi + ((lane & 15) >> 2)) * 144 + (16 * ((lane >> 4) & 1) + 4 * (lane & 3)) * 2;
#pragma unroll 1
    for (int j = jlo; j < 5; ++j) {
        const int kb = i0 - 128 + 32 * j;
        v4u vx[4];
#pragma unroll
        for (int p = 0; p < 4; ++p) { const int row = (lane >> 3) + 8 * p, piece = lane & 7; vx[p] = *(const v4u*)(vp + (tok0 + (long)stride * (kb + row)) * QP + piece * 8); }
        f32x16 S = band_scores(kp, qr, tok0, stride, i0, j, slope2, maxd, r32, hi);
#pragma unroll
        for (int r = 0; r < 16; ++r) { const float p = __builtin_amdgcn_exp2f(S[r] - m); S[r] = p; l += p; }
#pragma unroll
        for (int p = 0; p < 4; ++p) { const int row = (lane >> 3) + 8 * p, piece = lane & 7; *(LAS v4u*)(wl + row * 144 + piece * 16) = vx[p]; }
        WBAR();
#pragma unroll
        for (int s = 0; s < 2; ++s) {
            v4u pw; pw.x = pk2(S[8 * s + 0], S[8 * s + 1]); pw.y = pk2(S[8 * s + 2], S[8 * s + 3]); pw.z = pk2(S[8 * s + 4], S[8 * s + 5]); pw.w = pk2(S[8 * s + 6], S[8 * s + 7]);
            const bf16x8 pa = __builtin_bit_cast(bf16x8, pw);
#pragma unroll
            for (int db = 0; db < 2; ++db) { const s16x4 lo = vtr(vrd + 16 * s * 144 + db * 64), hh = vtr(vrd + (16 * s + 8) * 144 + db * 64);
                o[db] = __builtin_amdgcn_mfma_f32_32x32x16_bf16(pa, cat8(lo, hh), o[db], 0, 0, 0); }
        }
        WBAR();
        asm volatile("" ::: "memory");
    }
    l += __shfl_xor(l, 32);
    if (has_sink) l += __builtin_amdgcn_exp2f(sink2 - m);
    LAS float* wsf = (LAS float*)(wl + 4608);
    if (MODE == 0) {
        if (hi == 0) wsf[r32] = __builtin_amdgcn_rcpf(l);
        WBAR();
#pragma unroll
        for (int r = 0; r < 16; ++r) { const int q = crow(r, hi); const float inv = wsf[q]; hb16* orow = op + (tok0 + (long)stride * (i0 + q)) * QP;
            orow[r32] = (hb16)f2bf(o[0][r] * inv); orow[32 + r32] = (hb16)f2bf(o[1][r] * inv); }
        WBAR();
    } else if (MODE == 1) {
        if (hi == 0) { float* ml = pml + (tok0 + (long)stride * (i0 + r32)) * 16; ml[0] = m; ml[1] = l; }
#pragma unroll
        for (int r = 0; r < 16; ++r) { const int q = crow(r, hi); hb16* orow = pu + (tok0 + (long)stride * (i0 + q)) * 512;
            orow[r32] = (hb16)f2bf(o[0][r]); orow[32 + r32] = (hb16)f2bf(o[1][r]); }
    } else {
        const long tq = tok0 + (long)stride * (i0 + r32);
        const float m1 = pml1[tq * 16], l1 = pml1[tq * 16 + 1], m2 = pml2[tq * 16], l2 = pml2[tq * 16 + 1];
        const float M = fmaxf(m, fmaxf(m1, m2)); const float f0 = __builtin_amdgcn_exp2f(m - M), f1 = __builtin_amdgcn_exp2f(m1 - M), f2 = __builtin_amdgcn_exp2f(m2 - M);
        const float inv = 1.f / (f0 * l + f1 * l1 + f2 * l2);
        if (hi == 0) { wsf[r32] = f0 * inv; wsf[32 + r32] = f1 * inv; wsf[64 + r32] = f2 * inv; }
        WBAR();
#pragma unroll 4
        for (int r = 0; r < 16; ++r) { const int q = crow(r, hi); const long tk = tok0 + (long)stride * (i0 + q); const float w0 = wsf[q], w1 = wsf[32 + q], w2 = wsf[64 + q];
            const hb16* u1 = pu1 + tk * 512; const hb16* u2 = pu2 + tk * 512; hb16* orow = op + tk * QP;
            orow[r32] = (hb16)f2bf(w0 * o[0][r] + w1 * bf1(u1[r32]) + w2 * bf1(u2[r32]));
            orow[32 + r32] = (hb16)f2bf(w0 * o[1][r] + w1 * bf1(u1[32 + r32]) + w2 * bf1(u2[32 + r32])); }
        WBAR();
    }
}
__device__ __forceinline__ float slope_of(int branch, int h) { return exp2f(-(float)(3 * h + 1 + branch) * (1.f / 3.f)); }

__device__ __forceinline__ float dpp_f(float x, int which) {
    const int v = __float_as_int(x);
    return __int_as_float(which == 0 ? __builtin_amdgcn_mov_dpp(v, 0xB1, 0xF, 0xF, true) : __builtin_amdgcn_mov_dpp(v, 0x4E, 0xF, 0xF, true));
}
__device__ __forceinline__ int wave_isum(int x) {
    x += __builtin_amdgcn_mov_dpp(x, 0xB1, 0xF, 0xF, true);
    x += __builtin_amdgcn_mov_dpp(x, 0x4E, 0xF, 0xF, true);
    x += __builtin_amdgcn_mov_dpp(x, 0x141, 0xF, 0xF, true);
    x += __builtin_amdgcn_mov_dpp(x, 0x140, 0xF, 0xF, true);
    return __builtin_amdgcn_readlane(x, 0) + __builtin_amdgcn_readlane(x, 16) + __builtin_amdgcn_readlane(x, 32) + __builtin_amdgcn_readlane(x, 48);
}
__device__ __forceinline__ int wave_excl_scan(int x, int lane) {
    int incl = x;
#pragma unroll
    for (int o = 1; o < 64; o <<= 1) { const int n = __shfl_up(incl, o); if (lane >= o) incl += n; }
    return incl - x;
}
constexpr int SC_PITCH = 64 * 65 + 4;
__device__ __forceinline__ void indexer_step(Frame& F, int b, int sl) {
    const int lane = F.lane, wave = F.wave, r32 = lane & 31, hi = lane >> 5;
    const int t0 = 8 * sl; const long tokb = (long)b * SEQ;
    const int ntile = (t0 + 8 + 31) >> 5;
    const int qq = r32 >> 2, hh = r32 & 3;
    const hb16* QKV = F.BIG();
    const hb16* iqrow = QKV + (tokb + t0 + qq) * QP + COL_IQ + 64 * hh;
    bf16x8 qf[4];
#pragma unroll
    for (int s = 0; s < 4; ++s) qf[s] = *(const bf16x8*)(iqrow + 16 * s + 8 * hi);
    const float iw = F.side()[(tokb + t0 + qq) * 16 + hh];
    LAS float* sc = (LAS float*)F.lds;
    for (int tile = wave; tile < ntile; tile += 8) {
        const hb16* krow = QKV + (tokb + 32 * tile + r32) * QP + COL_IK;
        f32x16 acc = {};
#pragma unroll
        for (int s = 0; s < 4; ++s) { const bf16x8 kf = *(const bf16x8*)(krow + 16 * s + 8 * hi); acc = __builtin_amdgcn_mfma_f32_32x32x16_bf16(kf, qf[s], acc, 0, 0, 0); }
#pragma unroll
        for (int g4 = 0; g4 < 4; ++g4) { float v[4];
#pragma unroll
            for (int e = 0; e < 4; ++e) { float x = iw * fmaxf(acc[4 * g4 + e], 0.f); x += dpp_f(x, 0); x += dpp_f(x, 1); v[e] = x; }
            float sel = hh == 0 ? v[0] : hh == 1 ? v[1] : hh == 2 ? v[2] : v[3];
            sel = (sel == 0.f) ? 0.f : sel;
            const int kv = 32 * tile + 8 * g4 + 4 * hi + hh;
            sc[qq * SC_PITCH + kv + (kv >> 6)] = sel; }
    }
    __syncthreads();
    {
        const int t = t0 + wave; unsigned short* out = F.idx() + (tokb + t) * 256;
        if (t < 256) {
#pragma unroll
            for (int j = 0; j < 4; ++j) { const int kv = j * 64 + lane; out[kv] = (unsigned short)((kv <= t) ? kv : 0xFFFF); }
        } else {
            const LAS float* s = sc + wave * SC_PITCH + lane * 65;
            unsigned key[64];
#pragma unroll
            for (int j = 0; j < 64; ++j) { const int kv = 64 * lane + j; const unsigned bits = __float_as_uint(s[j]); const unsigned k = bits ^ ((bits >> 31) ? 0xFFFFFFFFu : 0x80000000u); key[j] = (kv <= t) ? k : 0u; }
            unsigned prefix = 0u; bool exact = false;
            for (int bit = 31; bit >= 0; --bit) {
                const unsigned cand = prefix | (1u << bit); int c = 0;
#pragma unroll
                for (int j = 0; j < 64; ++j) c += (key[j] >= cand) ? 1 : 0;
                const int cnt = wave_isum(c);
                if (cnt >= 256) { prefix = cand; if (cnt == 256) { exact = true; break; } }
            }
            int ngt = 0, neq = 0;
#pragma unroll
            for (int j = 0; j < 64; ++j) { ngt += (key[j] > prefix) ? 1 : 0; neq += (key[j] == prefix) ? 1 : 0; }
            const int need = exact ? (1 << 30) : 256 - wave_isum(ngt);
            int eqr = wave_excl_scan(neq, lane);
            const int selc = ngt + max(0, min(neq, need - eqr));
            int pos = wave_excl_scan(selc, lane);
            asm volatile("" : "+v"(prefix));
#pragma unroll
            for (int j = 0; j < 64; ++j) { const bool gt = key[j] > prefix, eq = key[j] == prefix; const bool sel = gt || (eq && eqr < need);
                if (sel && pos < 256) out[pos] = (unsigned short)(64 * lane + j);
                pos += sel ? 1 : 0; eqr += eq ? 1 : 0; }
        }
    }
    __syncthreads();
}
__device__ __forceinline__ void dsa_query(Frame& F, long tokb, int t, bool store_en, LAS unsigned char* wl, int lane) {
    const int c = lane & 15, g = lane >> 4, h = c & 7; const long tok = tokb + t;
    hb16* QKV = F.BIG();
    const hb16* qp = QKV + tok * QP + COL_QC + 64 * h;
    const bf16x8 qf0 = *(const bf16x8*)(qp + 8 * g), qf1 = *(const bf16x8*)(qp + 32 + 8 * g);
    const unsigned short* ix = F.idx() + tok * 256;
    const float slope2 = exp2f(-(float)(h + 1)) * LOG2E;
    f32x4 S[16];
#pragma unroll
    for (int i = 0; i < 16; ++i) {
        unsigned kr = ix[16 * i + c]; if (kr > (unsigned)t) kr = 0u;
        const hb16* kp = QKV + (tokb + kr) * QP + COL_KC;
        const bf16x8 k0 = *(const bf16x8*)(kp + 8 * g), k1 = *(const bf16x8*)(kp + 32 + 8 * g);
        f32x4 acc = {0.f, 0.f, 0.f, 0.f};
        acc = __builtin_amdgcn_mfma_f32_16x16x32_bf16(k0, qf0, acc, 0, 0, 0); acc = __builtin_amdgcn_mfma_f32_16x16x32_bf16(k1, qf1, acc, 0, 0, 0);
        const v2u i4 = *(const v2u*)(ix + 16 * i + 4 * g);
        const int id0 = i4.x & 0xffff, id1 = i4.x >> 16, id2 = i4.y & 0xffff, id3 = i4.y >> 16;
        S[i][0] = (id0 <= t) ? acc[0] - slope2 * (float)(t - id0) : -INFINITY; S[i][1] = (id1 <= t) ? acc[1] - slope2 * (float)(t - id1) : -INFINITY;
        S[i][2] = (id2 <= t) ? acc[2] - slope2 * (float)(t - id2) : -INFINITY; S[i][3] = (id3 <= t) ? acc[3] - slope2 * (float)(t - id3) : -INFINITY;
    }
    float m = -INFINITY;
#pragma unroll
    for (int i = 0; i < 16; ++i) m = fmaxf(m, fmaxf(fmaxf(S[i][0], S[i][1]), fmaxf(S[i][2], S[i][3])));
    m = fmaxf(m, __shfl_xor(m, 16)); m = fmaxf(m, __shfl_xor(m, 32));
    float l = 0.f;
#pragma unroll
    for (int i = 0; i < 16; ++i)
#pragma unroll
        for (int e = 0; e < 4; ++e) { const float p = __builtin_amdgcn_exp2f(S[i][e] - m); S[i][e] = p; l += p; }
    l += __shfl_xor(l, 16); l += __shfl_xor(l, 32);
    f32x4 o[4];
#pragma unroll
    for (int dt = 0; dt < 4; ++dt) o[dt] = (f32x4){0.f, 0.f, 0.f, 0.f};
    const LAS unsigned char* vrd = wl + (4 * g + ((lane & 15) >> 2)) * 144 + 4 * (lane & 3) * 2;
#pragma unroll
    for (int ch = 0; ch < 4; ++ch) {
#pragma unroll
        for (int p = 0; p < 8; ++p) { const int row = (lane >> 3) + 8 * p, piece = lane & 7; unsigned vr = ix[64 * ch + row]; if (vr > (unsigned)t) vr = 0u;
            const v4u x = *(const v4u*)(QKV + (tokb + vr) * QP + COL_VC + piece * 8); *(LAS v4u*)(wl + row * 144 + piece * 16) = x; }
        WBAR();
#pragma unroll
        for (int u2 = 0; u2 < 2; ++u2) { const int u = 2 * ch + u2;
            v4u pw; pw.x = pk2(S[2 * u][0], S[2 * u][1]); pw.y = pk2(S[2 * u][2], S[2 * u][3]); pw.z = pk2(S[2 * u + 1][0], S[2 * u + 1][1]); pw.w = pk2(S[2 * u + 1][2], S[2 * u + 1][3]);
            const bf16x8 pb = __builtin_bit_cast(bf16x8, pw);
#pragma unroll
            for (int dt = 0; dt < 4; ++dt) { const s16x4 lo = vtr(vrd + (32 * u2) * 144 + dt * 32), hh = vtr(vrd + (32 * u2 + 16) * 144 + dt * 32);
                o[dt] = __builtin_amdgcn_mfma_f32_16x16x32_bf16(cat8(lo, hh), pb, o[dt], 0, 0, 0); }
        }
        WBAR();
        asm volatile("" ::: "memory");
    }
    if (c < 8 && store_en) { const float inv = 1.f / l; hb16* op = QKV + tok * QP + COL_QC + 64 * h + 4 * g;
#pragma unroll
        for (int dt = 0; dt < 4; ++dt) { v2u w; w.x = pk2(o[dt][0] * inv, o[dt][1] * inv); w.y = pk2(o[dt][2] * inv, o[dt][3] * inv); *(v2u*)(op + 16 * dt) = w; } }
}

#define XB_TMO      128
#define XB_XCNT(j)  (256  + 64 * (j))
#define XB_XSUB(j)  (1280 + 64 * (j))
#define XB_XGEN(j)  (2304 + 64 * (j))
#define XB_TOP      3328
#define XB_TOPGEN   3392
#define XCD_BAR_WORDS 3456
#define XB_SPIN_CAP (1u << 18)

__device__ __forceinline__ unsigned xb_ld(unsigned* p)              { return __hip_atomic_load(p, __ATOMIC_RELAXED, __HIP_MEMORY_SCOPE_AGENT); }
__device__ __forceinline__ unsigned xb_add(unsigned* p, unsigned v) { return __hip_atomic_fetch_add(p, v, __ATOMIC_RELAXED, __HIP_MEMORY_SCOPE_AGENT); }
__device__ __forceinline__ unsigned xb_xcc_id() { return (unsigned)__builtin_amdgcn_s_getreg((3 << 11) | 20) & 0xFu; }
#define XB_SPIN(cond, bar) do { unsigned _sp = 0; while (cond) { __builtin_amdgcn_s_sleep(1); \
    if ((++_sp & 255u) == 0u) { if (xb_ld(&(bar)[XB_TMO])) break; if (_sp > XB_SPIN_CAP) { atomicAdd(&(bar)[XB_TMO], 1u); break; } } } } while (0)

struct XcdBarrier {
    unsigned* bar; unsigned x;
    volatile LAS unsigned* st;
};

__device__ __forceinline__ XcdBarrier xcd_barrier_post(unsigned* bar, volatile LAS unsigned* st) {
    XcdBarrier b; b.bar = bar; b.x = xb_xcc_id(); b.st = st;
    if (threadIdx.x == 0) (void)xb_add(&bar[XB_XCNT(b.x)], 1u);
    return b;
}
__device__ __forceinline__ void xcd_barrier_complete(unsigned* bar, unsigned x, unsigned& nloc, unsigned& nx) {
    const unsigned G = gridDim.x * gridDim.y * gridDim.z;
    unsigned sum, cnt, mine, sp = 0u;
    for (;;) {
        sum = 0u; cnt = 0u; mine = 0u;
#pragma unroll
        for (unsigned j = 0; j < 16; ++j) { const unsigned c = xb_ld(&bar[XB_XCNT(j)]); sum += c; cnt += (c > 0u) ? 1u : 0u; mine = (j == x) ? c : mine; }
        if (sum == G) break;
        __builtin_amdgcn_s_sleep(1);
        if ((++sp & 255u) == 0u) { if (xb_ld(&bar[XB_TMO])) break; if (sp > XB_SPIN_CAP) { atomicAdd(&bar[XB_TMO], 1u); break; } }
    }
    nloc = mine > 0u ? mine : 1u; nx = cnt > 0u ? cnt : 1u;
}

__device__ __forceinline__ void xcd_barrier(const XcdBarrier& b) {
    asm volatile("s_waitcnt vmcnt(0)" ::: "memory");
    __syncthreads();
    if (threadIdx.x == 0) {
        unsigned* bar = b.bar;
        __builtin_amdgcn_s_waitcnt(0);
        unsigned nloc = b.st[0], nx = b.st[1];
        if (nloc == 0u) { xcd_barrier_complete(bar, b.x, nloc, nx); b.st[0] = nloc; b.st[1] = nx; }
        const unsigned old = xb_add(&bar[XB_XSUB(b.x)], 1u);
        const unsigned gen = old / nloc;
        if (old + 1u == (gen + 1u) * nloc) {
            __builtin_amdgcn_fence(__ATOMIC_RELEASE, "agent");
            asm volatile("s_waitcnt vmcnt(0)" ::: "memory");
            const unsigned og = xb_add(&bar[XB_TOP], 1u);
            const unsigned tg = og / nx;
            if (og + 1u == (tg + 1u) * nx) xb_add(&bar[XB_TOPGEN], 1u);
            else XB_SPIN(xb_ld(&bar[XB_TOPGEN]) == tg, bar);
            __builtin_amdgcn_fence(__ATOMIC_ACQUIRE, "agent");
            xb_add(&bar[XB_XGEN(b.x)], 1u);
            asm volatile("s_waitcnt vmcnt(0)" ::: "memory");
        } else {
            XB_SPIN(xb_ld(&bar[XB_XGEN(b.x)]) == gen, bar);
            __builtin_amdgcn_fence(__ATOMIC_ACQUIRE, "agent");
            asm volatile("s_waitcnt vmcnt(0)" ::: "memory");
        }
    }
    __syncthreads();
}

constexpr int N_PHASES = 1 + 10 * NLAYER;
#ifndef DBG_MASK
#define DBG_MASK 0x7ff
#endif
#ifndef DBG_SUB
#define DBG_SUB 7
#endif
#define DBGK(k) (((DBG_MASK) >> (k)) & 1)
#define DSUB(k) (((DBG_SUB) >> (k)) & 1)
#ifndef PRB_G1
#define PRB_G1 1
#endif
#ifndef PRB_BAND
#define PRB_BAND 1
#endif
#ifndef PRB_IDX
#define PRB_IDX 1
#endif
#ifndef PRB_FOX
#define PRB_FOX 1
#endif
#ifndef PRB_DSA
#define PRB_DSA 1
#endif
#ifndef PRB_G2
#define PRB_G2 1
#endif
#ifndef PRB_G3
#define PRB_G3 1
#endif
#ifndef PRB_G4
#define PRB_G4 1
#endif
#ifndef PRB_G5
#define PRB_G5 1
#endif
#ifndef PRB_LN
#define PRB_LN 1
#endif
#ifndef USE_CG_FIRST
#define USE_CG_FIRST 1
#endif
#ifndef PRB_SYNC
#define PRB_SYNC 1
#endif
#ifndef PRB_CVT
#define PRB_CVT 1
#endif

__global__ void __launch_bounds__(NWAVES * 64, 2) mixer_fwd(Args args) {
    extern __shared__ __attribute__((aligned(16))) unsigned char lds[];
    cg::grid_group grid = cg::this_grid();
    const int lo = args.ph_lo, hi = args.ph_hi;
    volatile LAS unsigned* bst = (volatile LAS unsigned*)((LAS unsigned char*)lds + LDS_BYTES - 64);
    if (threadIdx.x < 16) bst[threadIdx.x] = 0u;
    __syncthreads();
    XcdBarrier xbar; xbar.bar = (unsigned*)(args.ws + WS_CTL); xbar.x = 0; xbar.st = bst;
    if (hi - lo > 1) xbar = xcd_barrier_post((unsigned*)(args.ws + WS_CTL), bst);
#pragma unroll 1
    for (int ph = lo; ph < hi; ++ph) {
        Frame F;
        { int tid_ = threadIdx.x; asm volatile("" : "+v"(tid_)); F.tid = tid_; }
        F.lds = (LAS unsigned char*)lds; F.lane = F.tid & 63; F.wave = __builtin_amdgcn_readfirstlane(F.tid >> 6);
        F.G = gridDim.x; { const int bx = blockIdx.x; F.vcu = (F.G % 8 == 0) ? (bx % 8) * (F.G / 8) + bx / 8 : bx; }
        F.out = args.out; F.ws = args.ws;
        const int gw = F.vcu * NWAVES + F.wave;
        LAS unsigned char* wl = F.lds + F.wave * 16384;
        const int l = (ph == 0) ? 0 : (ph - 1) / 10, k = (ph == 0) ? 10 : (ph - 1) % 10;
        switch (k) {
        case 10:
            if (DBGK(10)) { for (int rp = 0; rp < PRB_CVT; ++rp) convert_weights(F, args, 0); x_to_bf16(F, args.in[0]); }
            break;
        case 0:
            if (DBGK(0)) {
                pg8::Gemm g{F.XB(), F.Win_t(), DM, DM}; pg8::StaticOrder S; S.init(T, QP, F.G, (int)blockIdx.x);
                pg8::EpiBf16 E{F.BIG(), QP, F.side(), 18};
                for (int rp = 0; rp < PRB_G1; ++rp) pg8::gemm_phase<pg8::EpiBf16, pg8::StaticOrder, true>(F.lds, g, S, E);
            }
            break;
        case 1:
            if (DBGK(1)) {
                if (DSUB(0) && blockIdx.x < 32) cumsum_task(F, args.in[2] + l * 8, (int)blockIdx.x);
                if (DSUB(1)) for (int u = gw; u < 4096; u += F.G * NWAVES) {
                    const int h = u & 7, blk = (u >> 3) & 127, b = u >> 10; const long tb = (long)b * SEQ;
                    banded_unit<0>(F.BIG() + COL_QA + 64 * h, F.BIG() + COL_KA + 64 * (h >> 2), F.BIG() + COL_VA + 64 * (h >> 2), tb, 1, 32 * blk, slope_of(0, h) * LOG2E, 127,
                                   args.in[3][l * 8 + h] * LOG2E, true, F.BIG() + COL_QA + 64 * h, nullptr, nullptr, nullptr, nullptr, nullptr, nullptr, wl, F.lane);
                    for (int rp = 0; rp < PRB_BAND; ++rp) banded_unit<1>(F.BIG() + COL_QB + 64 * h, F.BIG() + COL_KB + 64 * h, F.BIG() + COL_VB + 64 * h, tb, 1, 32 * blk, slope_of(1, h) * LOG2E, 128, 0.f, false,
                                   nullptr, F.pu1() + 64 * h, F.pml1() + 2 * h, nullptr, nullptr, nullptr, nullptr, wl, F.lane);
                    for (int rp = 0; rp < PRB_BAND; ++rp) banded_unit<1>(F.BIG() + COL_QB + 64 * h, F.BIG() + COL_KB + 64 * h, F.BIG() + COL_VB + 64 * h, tb + (blk & 3), 4, 32 * (blk >> 2), slope_of(1, h) * 4.f * LOG2E, 128, 0.f, false,
                                   nullptr, F.pu2() + 64 * h, F.pml2() + 2 * h, nullptr, nullptr, nullptr, nullptr, wl, F.lane);
                }
                __syncthreads();
                if (DSUB(2)) for (int rp = 0; rp < PRB_IDX; ++rp) for (int b = 0; b < NB; ++b) { const int c = (int)blockIdx.x; if (c < 256) { indexer_step(F, b, c); indexer_step(F, b, 511 - c); } }
            }
            break;
        case 2:
            if (DBGK(2)) {
                if (DSUB(0)) for (int rp = 0; rp < PRB_FOX; ++rp) for (int i = 0; i < 2; ++i) { const int v = F.vcu; if (v < 256) { const int s = v & 7, bh = v >> 3, qb = (i == 0) ? s : 15 - s;
                    fox::attn_unit<8>(bh >> 3, bh & 7, qb, (const fox::bf16*)(F.BIG() + COL_QD), (const fox::bf16*)(F.BIG() + COL_KD), (const fox::bf16*)(F.BIG() + COL_VD), (fox::bf16*)(F.BIG() + COL_QD), F.cb(), rp == PRB_FOX - 1, (char*)lds); } }
                __syncthreads();
                if (DSUB(1)) for (int rp = 0; rp < PRB_DSA; ++rp) for (int q = gw; q < T; q += F.G * NWAVES) dsa_query(F, (long)(q >> 12) * SEQ, q & (SEQ - 1), rp == PRB_DSA - 1, wl, F.lane);
                if (DSUB(2)) for (int u = gw; u < 4096; u += F.G * NWAVES) {
                    const int h = u & 7, blk = (u >> 3) & 127, b = u >> 10; const long tb = (long)b * SEQ;
                    banded_unit<2>(F.BIG() + COL_QB + 64 * h, F.BIG() + COL_KB + 64 * h, F.BIG() + COL_VB + 64 * h, tb + (blk & 15), 16, 32 * (blk >> 4), slope_of(1, h) * 16.f * LOG2E, 128, 0.f, false,
                                   F.BIG() + COL_QB + 64 * h, nullptr, nullptr, F.pu1() + 64 * h, F.pml1() + 2 * h, F.pu2() + 64 * h, F.pml2() + 2 * h, wl, F.lane);
                }
            }
            break;
        case 3:
            if (DBGK(3)) {
                pg8::StaticOrder S; S.init(T, DM, F.G, (int)blockIdx.x); pg8::FixedUnit FU; FU.have = S.next(0, FU.u0);
                unsigned char* scr = (unsigned char*)F.out + (size_t)blockIdx.x * 131072;
#pragma unroll 1
                for (int rp = 0; rp < PRB_G2; ++rp)
#pragma unroll 1
                for (int n = 0; n < 4; ++n) {
                    { pg8::Gemm g{F.XB(), F.Wg_t() + (size_t)n * 1024 * DM, DM, DM}; pg8::EpiGate E{scr, args.in[6] + (size_t)l * 4096 + n * 1024};
                      pg8::gemm_phase<pg8::EpiGate, pg8::FixedUnit, false>(F.lds, g, FU, E); }
                    { pg8::Gemm g{F.BIG() + 512 * n, F.Wb_t() + (size_t)n * 1024 * 512, QP, 512}; pg8::EpiProj E{scr, F.BIG() + COL_MRG, QP, n == 0};
                      pg8::gemm_phase<pg8::EpiProj, pg8::FixedUnit, false>(F.lds, g, FU, E); }
                }
            }
            break;
        case 4:
            if (DBGK(4)) {
                pg8::Gemm g{F.BIG() + COL_MRG, F.Wo_t(), QP, DM}; pg8::StaticOrder S; S.init(T, DM, F.G, (int)blockIdx.x);
                pg8::EpiResF32 E{F.XB(), DM, F.out, DM, ALPHA};
                for (int rp = 0; rp < PRB_G3; ++rp) pg8::gemm_phase<pg8::EpiResF32, pg8::StaticOrder, false>(F.lds, g, S, E);
            }
            break;
        case 5:
            if (DBGK(5)) for (int rp = 0; rp < PRB_LN; ++rp) ln_phase(F, args.in[8] + (size_t)l * DM, args.in[9] + (size_t)l * DM, false);
            break;
        case 6:
            if (DBGK(6)) {
                pg8::Gemm g{F.XB(), F.Wuf_t(), DM, DM}; pg8::StaticOrder S; S.init(T, FP, F.G, (int)blockIdx.x);
                pg8::EpiBf16 E{F.BIG(), FP, nullptr, -1};
                for (int rp = 0; rp < PRB_G4; ++rp) pg8::gemm_phase<pg8::EpiBf16, pg8::StaticOrder, true>(F.lds, g, S, E);
            }
            break;
        case 7:
            if (DBGK(7)) ffn_elem_phase(F, args.in[12] + (size_t)l * 3 * DFF, args.in[13] + (size_t)l * DFF);
            break;
        case 8:
            if (DBGK(8)) {
                pg8::Gemm g{F.BIG() + DFF, F.Wd_t(), FP, DFF}; pg8::StaticOrder S; S.init(T, DM, F.G, (int)blockIdx.x);
                pg8::EpiResF32 E{F.XB(), DM, F.out, DM, ALPHA};
                for (int rp = 0; rp < PRB_G5; ++rp) pg8::gemm_phase<pg8::EpiResF32, pg8::StaticOrder, false>(F.lds, g, S, E);
            }
            break;
        default:
            if (DBGK(9)) {
                ln_phase(F, args.in[15] + (size_t)l * DM, args.in[16] + (size_t)l * DM, l == NLAYER - 1);
                if (l + 1 < NLAYER) convert_weights(F, args, l + 1);
            }
            break;
        }
        if (ph + 1 < hi) for (int rp = 0; rp < PRB_SYNC; ++rp) { if (ph == lo && USE_CG_FIRST) grid.sync(); else xcd_barrier(xbar); }
    }
}

#ifndef MK_ONE_LAUNCH
#define MK_ONE_LAUNCH 1
#endif
extern "C" void kernel_launch(void* const* d_in, const int* in_sizes, int n_in, void* d_out, int out_size, void* d_ws, size_t ws_size, hipStream_t stream) {
    static int grid = 0;
    if (grid == 0) {
        if (n_in != 17 || out_size != T * DM || ws_size < WS_END) { fprintf(stderr, "kernel_launch: unexpected shapes (n_in %d out %d ws %zu)\n", n_in, out_size, ws_size); grid = -1; return; }
        int dev = 0, cus = 0, per_cu = 0;
        if (hipGetDevice(&dev) != hipSuccess || hipDeviceGetAttribute(&cus, hipDeviceAttributeMultiprocessorCount, dev) != hipSuccess) { grid = -1; return; }
        if (hipFuncSetAttribute((const void*)mixer_fwd, hipFuncAttributeMaxDynamicSharedMemorySize, LDS_BYTES) != hipSuccess) { fprintf(stderr, "kernel_launch: hipFuncSetAttribute failed\n"); grid = -1; return; }
        if (hipOccupancyMaxActiveBlocksPerMultiprocessor(&per_cu, (const void*)mixer_fwd, NWAVES * 64, LDS_BYTES) != hipSuccess || per_cu < 1) { fprintf(stderr, "kernel_launch: occupancy query says %d\n", per_cu); per_cu = 1; }
        (void)hipGetLastError();
        grid = cus;
        if (grid != 256) fprintf(stderr, "kernel_launch: %d CUs (built for 256)\n", grid);
    }
    if (grid < 0) return;
    Args a{};
    for (int i = 0; i < 17; ++i) a.in[i] = (const float*)d_in[i];
    a.out = (float*)d_out; a.ws = (unsigned char*)d_ws;
#if MK_ONE_LAUNCH
    if (hipMemsetAsync((char*)d_ws + WS_CTL, 0, CTL_ZERO_BYTES, stream) != hipSuccess) { fprintf(stderr, "kernel_launch: memset failed\n"); return; }
    a.ph_lo = 0; a.ph_hi = N_PHASES;
    void* kargs[] = {&a};
    hipError_t e = hipLaunchCooperativeKernel((const void*)mixer_fwd, dim3(grid), dim3(NWAVES * 64), kargs, LDS_BYTES, stream);
    if (e != hipSuccess) fprintf(stderr, "kernel_launch: cooperative launch failed: %s\n", hipGetErrorString(e));
#else
    for (int p = 0; p < N_PHASES; ++p) {
        a.ph_lo = p; a.ph_hi = p + 1;
        hipLaunchKernelGGL(mixer_fwd, dim3(grid), dim3(NWAVES * 64), LDS_BYTES, stream, a);
    }
#endif
}
```

```cpp
#include <hip/hip_runtime.h>
#include <hip/hip_cooperative_groups.h>
#include <hip/hip_bf16.h>
#include <cstdio>
#include <cstdint>
#include <cmath>
namespace cg = cooperative_groups;

namespace pg8 {
#define PG8_LAS __attribute__((address_space(3)))
typedef unsigned short bf16_t;
typedef short bf16x8 __attribute__((ext_vector_type(8)));
typedef float f32x4 __attribute__((ext_vector_type(4)));
typedef float f32x2 __attribute__((ext_vector_type(2)));
typedef unsigned u32x4 __attribute__((ext_vector_type(4)));
typedef unsigned u32x2 __attribute__((ext_vector_type(2)));
constexpr int BM = 256, BK = 64, HALF = 128, HTB = HALF * BK * 2, STAGE_BYTES = 8 * HTB, NXCD = 8, WGM = 8;

__host__ __device__ __forceinline__ int lds_byte(int r, int c) { const int st = (r >> 4) * 2 + (c >> 5), rr = r & 15, cc = c & 31, ob = rr * 64 + cc * 2; return st * 1024 + (ob ^ (((ob >> 9) & 1) << 5)); }
__host__ __device__ __forceinline__ void stage_rc(int b, int& R, int& C) { const int st = b / 1024, sb = b % 1024, swz = sb ^ (((sb >> 9) & 1) << 5); R = (st >> 1) * 16 + swz / 64; C = (st & 1) * 32 + (swz % 64) / 2; }
__host__ __device__ __forceinline__ int perm32(int rho) { const int n = rho >> 4, i = rho & 15; return 8 * (i >> 2) + 4 * n + (i & 3); }

struct Unit { int pm, pn; };
struct Gemm { const bf16_t* A; const bf16_t* Bt; int lda, K; };

struct StaticOrder {
    int nM, nN, nwg, G, c;
    __host__ __device__ __forceinline__ void init(int M, int N, int G_, int c_) { nM = M / BM; nN = N / BM; nwg = nM * nN; G = G_; c = c_; }
    __host__ __device__ __forceinline__ bool next(int i, Unit& u) const {
        const long L = (long)i * G + c; if (L >= nwg) return false;
        int wgid = (int)L; { const int q = nwg / NXCD, r = nwg % NXCD, xcd = wgid % NXCD, off = wgid / NXCD; wgid = (xcd < r ? xcd * (q + 1) : r * (q + 1) + (xcd - r) * q) + off; }
        const int nig = WGM * nN, gid = wgid / nig, fm = gid * WGM, gsz = (nM - fm) < WGM ? (nM - fm) : WGM;
        u.pm = fm + ((wgid % nig) % gsz); u.pn = (wgid % nig) / gsz; return true;
    }
};
struct Work { const char* A; const char* B; int lda, K; Unit u; int tag; };
struct GridSched {
    StaticOrder so; Gemm g;
    __device__ __forceinline__ bool next(int i, Work& w) const { Unit u; if (!so.next(i, u)) return false;
        w.u = u; w.lda = g.lda; w.K = g.K; w.tag = 0; w.A = (const char*)g.A + (size_t)u.pm * 256 * g.lda * 2; w.B = (const char*)g.Bt + (size_t)u.pn * 256 * g.K * 2; return true; }
};
struct GateProjSched {
    Unit u0; bool have; const bf16_t* X; const bf16_t* Wg; const bf16_t* O; const bf16_t* Wb; int ldo;
    __device__ __forceinline__ bool next(int i, Work& w) const { if (i >= 8 || !have) return false; const int n = i >> 1; w.u = u0; w.tag = i;
        if ((i & 1) == 0) { w.lda = 1024; w.K = 1024; w.A = (const char*)X + (size_t)u0.pm * 256 * 1024 * 2; w.B = (const char*)(Wg + (size_t)n * 1024 * 1024) + (size_t)u0.pn * 256 * 1024 * 2; }
        else { w.lda = ldo; w.K = 512; w.A = (const char*)(O + 512 * n) + (size_t)u0.pm * 256 * ldo * 2; w.B = (const char*)(Wb + (size_t)n * 1024 * 512) + (size_t)u0.pn * 256 * 512 * 2; }
        return true; }
};

__device__ __forceinline__ unsigned cvt_pk_bf16(float lo, float hi) { unsigned r; asm volatile("v_cvt_pk_bf16_f32 %0, %1, %2" : "=v"(r) : "v"(lo), "v"(hi)); return r; }
__device__ __forceinline__ float bf_lo(unsigned w) { return __uint_as_float(w << 16); }
__device__ __forceinline__ float bf_hi(unsigned w) { return __uint_as_float(w & 0xffff0000u); }

struct EpiBf16 {
    static constexpr bool PERM = true;
    bf16_t* O; int ldc; float* side; int side_pn;
    __device__ __forceinline__ void operator()(const f32x4 (&acc)[2][2][4][2], const Unit& u, int tag, int wr, int wc, int fr, int fq) const {
        const int row0 = u.pm * BM + wr * 64 + fr; const int col0 = u.pn * BM + wc * 32 + 8 * fq;
        const bool sd = (side != nullptr) && (u.pn == side_pn) && (wc == 2) && (fq < 2);
#pragma unroll
        for (int ai = 0; ai < 2; ++ai)
#pragma unroll
            for (int m = 0; m < 4; ++m) { const int row = row0 + ai * HALF + m * 16; bf16_t* rowp = O + (size_t)row * ldc + col0;
#pragma unroll
                for (int bj = 0; bj < 2; ++bj) { const f32x4 v0 = acc[ai][bj][m][0], v1 = acc[ai][bj][m][1];
                    u32x4 w; w.x = cvt_pk_bf16(v0[0], v0[1]); w.y = cvt_pk_bf16(v0[2], v0[3]); w.z = cvt_pk_bf16(v1[0], v1[1]); w.w = cvt_pk_bf16(v1[2], v1[3]);
                    *(u32x4*)(rowp + bj * HALF) = w;
                    if (bj == 1 && sd) { float* sp = side + (size_t)row * 16 + 8 * fq; *(f32x4*)sp = v0; if (fq == 0) *(f32x4*)(sp + 4) = v1; } } }
    }
};
__device__ __forceinline__ u32x4* scr_slot(unsigned char* base, int k, int tid) { return (u32x4*)(base + (size_t)(k * 512 + tid) * 16); }
struct EpiGate {
    static constexpr bool PERM = true;
    unsigned char* scr; const float* bias;
    __device__ __forceinline__ void operator()(const f32x4 (&acc)[2][2][4][2], const Unit& u, int tag, int wr, int wc, int fr, int fq) const {
        int tid = threadIdx.x; asm volatile("" : "+v"(tid));
        const int col0 = u.pn * BM + wc * 32 + 8 * fq;
        f32x4 bv[2][2];
#pragma unroll
        for (int bj = 0; bj < 2; ++bj)
#pragma unroll
            for (int n = 0; n < 2; ++n) bv[bj][n] = *(const f32x4*)(bias + col0 + bj * HALF + 4 * n);
#pragma unroll
        for (int ai = 0; ai < 2; ++ai)
#pragma unroll
            for (int m = 0; m < 4; ++m)
#pragma unroll
                for (int bj = 0; bj < 2; ++bj) { f32x4 v0 = acc[ai][bj][m][0] + bv[bj][0], v1 = acc[ai][bj][m][1] + bv[bj][1];
#pragma unroll
                    for (int e = 0; e < 4; ++e) { v0[e] = __builtin_amdgcn_rcpf(1.f + __builtin_amdgcn_exp2f(-1.4426950408889634f * v0[e])); v1[e] = __builtin_amdgcn_rcpf(1.f + __builtin_amdgcn_exp2f(-1.4426950408889634f * v1[e])); }
                    u32x4 w; w.x = cvt_pk_bf16(v0[0], v0[1]); w.y = cvt_pk_bf16(v0[2], v0[3]); w.z = cvt_pk_bf16(v1[0], v1[1]); w.w = cvt_pk_bf16(v1[2], v1[3]);
                    *scr_slot(scr, (ai * 4 + m) * 2 + bj, tid) = w; asm volatile("" ::: "memory"); }
    }
};
struct EpiProj {
    static constexpr bool PERM = true;
    unsigned char* scr; bf16_t* Mg; int ldc; int first;
    __device__ __forceinline__ void operator()(const f32x4 (&acc)[2][2][4][2], const Unit& u, int tag, int wr, int wc, int fr, int fq) const {
        int tid = threadIdx.x; int row0 = u.pm * BM + wr * 64 + fr; asm volatile("" : "+v"(tid), "+v"(row0)); const int col0 = u.pn * BM + wc * 32 + 8 * fq;
#pragma unroll
        for (int ai = 0; ai < 2; ++ai)
#pragma unroll
            for (int m = 0; m < 4; ++m) { bf16_t* rowp = Mg + (size_t)(row0 + ai * HALF + m * 16) * ldc + col0;
#pragma unroll
                for (int bj = 0; bj < 2; ++bj) { const u32x4 gw = *scr_slot(scr, (ai * 4 + m) * 2 + bj, tid);
                    f32x4 v0 = acc[ai][bj][m][0], v1 = acc[ai][bj][m][1];
                    v0[0] *= bf_lo(gw.x); v0[1] *= bf_hi(gw.x); v0[2] *= bf_lo(gw.y); v0[3] *= bf_hi(gw.y); v1[0] *= bf_lo(gw.z); v1[1] *= bf_hi(gw.z); v1[2] *= bf_lo(gw.w); v1[3] *= bf_hi(gw.w);
                    if (!first) { const u32x4 ow = *(const u32x4*)(rowp + bj * HALF);
                        v0[0] += bf_lo(ow.x); v0[1] += bf_hi(ow.x); v0[2] += bf_lo(ow.y); v0[3] += bf_hi(ow.y); v1[0] += bf_lo(ow.z); v1[1] += bf_hi(ow.z); v1[2] += bf_lo(ow.w); v1[3] += bf_hi(ow.w); }
                    u32x4 w; w.x = cvt_pk_bf16(v0[0], v0[1]); w.y = cvt_pk_bf16(v0[2], v0[3]); w.z = cvt_pk_bf16(v1[0], v1[1]); w.w = cvt_pk_bf16(v1[2], v1[3]);
                    *(u32x4*)(rowp + bj * HALF) = w; asm volatile("" ::: "memory"); } }
    }
};
struct EpiGateProj {
    static constexpr bool PERM = true;
    unsigned char* scr; const float* bias4; bf16_t* Mg; int ldc;
    __device__ __forceinline__ void operator()(const f32x4 (&acc)[2][2][4][2], const Unit& u, int tag, int wr, int wc, int fr, int fq) const {
        if ((tag & 1) == 0) { EpiGate e{scr, bias4 + (tag >> 1) * 1024}; e(acc, u, tag, wr, wc, fr, fq); }
        else { EpiProj e{scr, Mg, ldc, tag == 1}; e(acc, u, tag, wr, wc, fr, fq); }
    }
};
struct EpiResF32 {
    static constexpr bool PERM = false;
    const bf16_t* res; int ldr; float* out; int ldc; float alpha;
    __device__ __forceinline__ void operator()(const f32x4 (&acc)[2][2][4][2], const Unit& u, int tag, int wr, int wc, int fr, int fq) const {
        const int row0 = u.pm * BM + wr * 64 + fr; const int col0 = u.pn * BM + wc * 32 + 4 * fq;
#pragma unroll
        for (int ai = 0; ai < 2; ++ai)
#pragma unroll
            for (int m = 0; m < 4; ++m) { const int row = row0 + ai * HALF + m * 16;
#pragma unroll
                for (int bj = 0; bj < 2; ++bj)
#pragma unroll
                    for (int n = 0; n < 2; ++n) { const int c = col0 + bj * HALF + n * 16; const u32x2 rw = *(const u32x2*)(res + (size_t)row * ldr + c);
                        f32x4 o = acc[ai][bj][m][n]; o[0] += alpha * bf_lo(rw.x); o[1] += alpha * bf_hi(rw.x); o[2] += alpha * bf_lo(rw.y); o[3] += alpha * bf_hi(rw.y);
                        *(f32x4*)(out + (size_t)row * ldc + c) = o; } }
    }
};

template <class Epi, class Sched, bool ALIGN_EPI>
__device__ __forceinline__ void gemm_phase(PG8_LAS unsigned char* lds, const Sched& S, const Epi& E) {
    int tid_ = threadIdx.x; asm volatile("" : "+v"(tid_));
    const int tid = tid_, wid = __builtin_amdgcn_readfirstlane(tid >> 6), lane = tid & 63, wr = wid >> 2, wc = wid & 3, fr = lane & 15, fq = lane >> 4;
    int sR[2], sC[2], sRb[2];
#pragma unroll
    for (int i = 0; i < 2; ++i) { int R, C; stage_rc(tid * 16 + i * 8192, R, C); sR[i] = R; sC[i] = C; sRb[i] = Epi::PERM ? ((R & ~31) + perm32(R & 31)) : R; }
    const size_t kstep = (size_t)(BK * 2);
    const unsigned ldsw = (unsigned)wid * 1024u;
    const int aoff = lds_byte(wr * 64 + fr, fq * 8), boff = lds_byte(wc * 32 + fr, fq * 8);
#define PG8_SA(b, h) (((b) * 2 + (h)) * HTB)
#define PG8_SB(b, h) ((4 + (b) * 2 + (h)) * HTB)
#define PG8_STAGE(bufoff, gbase, voff) do { _Pragma("unroll") for (int _i = 0; _i < 2; ++_i) \
        __builtin_amdgcn_global_load_lds((const unsigned*)((const char*)(gbase) + (voff)[_i]), (PG8_LAS unsigned*)(lds + (bufoff) + ldsw + _i * 8192), 16, 0, 0); } while (0)
#define PG8_LDA(dst, b, h) do { _Pragma("unroll") for (int m = 0; m < 4; ++m) _Pragma("unroll") for (int k = 0; k < 2; ++k) dst[m][k] = *(const PG8_LAS bf16x8*)(lds + PG8_SA(b, h) + aoff + m * 2048 + k * 1024); } while (0)
#define PG8_LDB(dst, b, h) do { _Pragma("unroll") for (int n = 0; n < 2; ++n) _Pragma("unroll") for (int k = 0; k < 2; ++k) dst[n][k] = *(const PG8_LAS bf16x8*)(lds + PG8_SB(b, h) + boff + n * 2048 + k * 1024); } while (0)
#define PG8_MMA(ai, bj, At, Bt) do { __builtin_amdgcn_s_setprio(1); _Pragma("unroll") for (int m = 0; m < 4; ++m) _Pragma("unroll") for (int n = 0; n < 2; ++n) _Pragma("unroll") for (int k = 0; k < 2; ++k) \
        acc[ai][bj][m][n] = __builtin_amdgcn_mfma_f32_16x16x32_bf16(Bt[n][k], At[m][k], acc[ai][bj][m][n], 0, 0, 0); __builtin_amdgcn_s_setprio(0); } while (0)
#define PG8_WAIT_V(n) asm volatile("s_waitcnt vmcnt(" #n ")" ::: "memory")
#define PG8_WAIT_L(n) asm volatile("s_waitcnt lgkmcnt(" #n ")" ::: "memory")
#define PG8_BAR __builtin_amdgcn_s_barrier()
#define PG8_SCHED __builtin_amdgcn_sched_barrier(0)
    Work cur, nxt; int ui = 0;
    if (!S.next(0, cur)) return;
    unsigned voffA[2], voffB[2], nvoffA[2], nvoffB[2];
#pragma unroll
    for (int i = 0; i < 2; ++i) { voffA[i] = (unsigned)(sR[i] * cur.lda + sC[i]) * 2u; voffB[i] = (unsigned)(sRb[i] * cur.K + sC[i]) * 2u; }
    size_t hstepA = (size_t)HALF * cur.lda * 2, hstepB = (size_t)HALF * cur.K * 2;
    f32x4 acc[2][2][4][2];
#pragma unroll
    for (int a = 0; a < 2; ++a)
#pragma unroll
        for (int b = 0; b < 2; ++b)
#pragma unroll
            for (int m = 0; m < 4; ++m)
#pragma unroll
                for (int n = 0; n < 2; ++n) acc[a][b][m][n] = (f32x4){0.f, 0.f, 0.f, 0.f};
    bf16x8 At[4][2], B0[2][2], B1[2][2];
    const char* cA = cur.A; const char* cB = cur.B;
    PG8_STAGE(PG8_SB(0, 0), cB, voffB); PG8_STAGE(PG8_SB(0, 1), cB + hstepB, voffB); PG8_STAGE(PG8_SA(0, 0), cA, voffA); PG8_STAGE(PG8_SA(0, 1), cA + hstepA, voffA);
    if (wr == 1) PG8_BAR;
    PG8_WAIT_V(2); PG8_BAR;
    PG8_STAGE(PG8_SB(1, 0), cB + kstep, voffB); PG8_STAGE(PG8_SA(1, 0), cA + kstep, voffA); PG8_STAGE(PG8_SB(1, 1), cB + hstepB + kstep, voffB);
    PG8_WAIT_V(6); PG8_BAR;
    for (;;) {
        const bool has_next = S.next(ui + 1, nxt);
        if (!has_next) nxt = cur;
        const char* nA = nxt.A; const char* nB = nxt.B;
        const size_t nhstepA = (size_t)HALF * nxt.lda * 2, nhstepB = (size_t)HALF * nxt.K * 2;
#pragma unroll
        for (int i = 0; i < 2; ++i) { nvoffA[i] = (unsigned)(sR[i] * nxt.lda + sC[i]) * 2u; nvoffB[i] = (unsigned)(sRb[i] * nxt.K + sC[i]) * 2u; }
        const int nt = cur.K / BK;
        for (int t = 0; t < nt; t += 2) {
            const bool last = (t == nt - 2);
            const char* a1 = cA + (size_t)(t + 1) * kstep;
            const char* a2 = last ? nA : cA + (size_t)(t + 2) * kstep; const char* b2 = last ? nB : cB + (size_t)(t + 2) * kstep;
            const char* a3 = a2 + kstep; const char* b3 = b2 + kstep;
            unsigned vA2[2], vB2[2];
#pragma unroll
            for (int i = 0; i < 2; ++i) { vA2[i] = last ? nvoffA[i] : voffA[i]; vB2[i] = last ? nvoffB[i] : voffB[i]; }
            const size_t hA2 = last ? nhstepA : hstepA, hB2 = last ? nhstepB : hstepB;
            PG8_LDB(B0, 0, 0); PG8_LDB(B1, 0, 1); PG8_SCHED; PG8_LDA(At, 0, 0); PG8_STAGE(PG8_SA(1, 1), a1 + hstepA, voffA);
            PG8_WAIT_V(8); PG8_WAIT_L(0); PG8_BAR; PG8_MMA(0, 0, At, B0); PG8_MMA(0, 1, At, B1); PG8_BAR; PG8_SCHED;
            PG8_LDA(At, 0, 1); PG8_STAGE(PG8_SB(0, 0), b2, vB2); PG8_STAGE(PG8_SB(0, 1), b2 + hB2, vB2); PG8_STAGE(PG8_SA(0, 0), a2, vA2);
            PG8_WAIT_V(8); PG8_WAIT_L(0); PG8_BAR; PG8_MMA(1, 0, At, B0); PG8_MMA(1, 1, At, B1); PG8_BAR; PG8_SCHED;
            PG8_LDB(B0, 1, 0); PG8_LDB(B1, 1, 1); PG8_SCHED; PG8_LDA(At, 1, 0); PG8_STAGE(PG8_SA(0, 1), a2 + hA2, vA2);
            PG8_WAIT_V(8); PG8_WAIT_L(0); PG8_BAR; PG8_MMA(0, 0, At, B0); PG8_MMA(0, 1, At, B1); PG8_BAR; PG8_SCHED;
            PG8_LDA(At, 1, 1); PG8_STAGE(PG8_SB(1, 0), b3, vB2); PG8_STAGE(PG8_SB(1, 1), b3 + hB2, vB2); PG8_STAGE(PG8_SA(1, 0), a3, vA2);
            PG8_WAIT_V(8); PG8_WAIT_L(0); PG8_BAR; PG8_MMA(1, 0, At, B0); PG8_MMA(1, 1, At, B1); PG8_BAR; PG8_SCHED;
        }
        if constexpr (ALIGN_EPI) { if (wr == 0) PG8_BAR; }
        E(acc, cur.u, cur.tag, wr, wc, fr, fq);
        if (!has_next) break;
#pragma unroll
        for (int a = 0; a < 2; ++a)
#pragma unroll
            for (int b = 0; b < 2; ++b)
#pragma unroll
                for (int m = 0; m < 4; ++m)
#pragma unroll
                    for (int n = 0; n < 2; ++n) acc[a][b][m][n] = (f32x4){0.f, 0.f, 0.f, 0.f};
        cur = nxt; cA = nA; cB = nB; ++ui; hstepA = nhstepA; hstepB = nhstepB;
#pragma unroll
        for (int i = 0; i < 2; ++i) { voffA[i] = nvoffA[i]; voffB[i] = nvoffB[i]; }
        if constexpr (ALIGN_EPI) { if (wr == 1) PG8_BAR; }
    }
    PG8_WAIT_V(0);
    if constexpr (!ALIGN_EPI) { if (wr == 0) PG8_BAR; }
    PG8_BAR;
#undef PG8_SA
#undef PG8_SB
#undef PG8_STAGE
#undef PG8_LDA
#undef PG8_LDB
#undef PG8_MMA
#undef PG8_WAIT_V
#undef PG8_WAIT_L
#undef PG8_BAR
#undef PG8_SCHED
}
}
namespace fox {
using bf16=__hip_bfloat16;
using bf16x8=__attribute__((ext_vector_type(8)))short;
using s16x4=__attribute__((ext_vector_type(4)))short;
using f32x16=__attribute__((ext_vector_type(16)))float;
using u32x4=__attribute__((ext_vector_type(4)))unsigned;
constexpr int BATCH=4,NHEAD=8,SEQ=4096,D=64,DM=4864;
constexpr int NW=8,QBLK=32,QB=QBLK*NW,KVBLK=64,NQB=SEQ/QB;
constexpr int ATTN_PITCH=DM, ATTN_UNIT_ROWS=QB;
__device__ __forceinline__ int crow(int r,int hi){return (r&3)+8*(r>>2)+4*hi;}
#define SBAR() __builtin_amdgcn_sched_barrier(0)
__device__ __forceinline__ void cmask(f32x16&p0,f32x16&p1,int jb,int qrel,int hi){
  const float NEG=-INFINITY; int kb=64*jb+4*hi;
  #pragma unroll
  for(int r=0;r<16;++r){int kv=kb+(r&3)+8*(r>>2); if(kv>qrel)p0[r]=NEG; if(kv+32>qrel)p1[r]=NEG;}
}

constexpr int NSLOT=3, SLOTB=8192;
constexpr int LDS_K=0, LDS_V=NSLOT*SLOTB, LDS_WS=2*NSLOT*SLOTB, LDS_OST=LDS_WS+NW*64*4, LDS_BIAS=LDS_OST+NW*4096, LDS_BYTES=LDS_BIAS+SEQ*4;
constexpr float C2=0.125f*1.4426950408889634f;
__device__ __forceinline__ void glds16(const void*gsrc,unsigned lds_dst){unsigned keep;
  asm volatile("s_mov_b32 %0, m0\n\ts_mov_b32 m0, %2\n\ts_nop 0\n\tglobal_load_lds_dwordx4 %1, off\n\ts_mov_b32 m0, %0":"=&s"(keep):"v"(gsrc),"s"(lds_dst):"memory");}
__device__ __forceinline__ float max3f(float a,float b,float c){float r;asm("v_max3_f32 %0, %1, %2, %3":"=v"(r):"v"(a),"v"(b),"v"(c));return r;}
__device__ __forceinline__ float max2f(float a,float b){float r;asm("v_max_f32_e32 %0, %1, %2":"=v"(r):"v"(a),"v"(b));return r;}
__device__ __forceinline__ float fadd_s(float a,float b){float r;asm("v_add_f32_e32 %0, %1, %2":"=v"(r):"v"(a),"v"(b));return r;}
__device__ __forceinline__ float fsub_s(float a,float b){float r;asm("v_sub_f32_e32 %0, %1, %2":"=v"(r):"v"(a),"v"(b));return r;}
typedef float f32x2_t __attribute__((ext_vector_type(2))); typedef __bf16 bf16x2_t __attribute__((ext_vector_type(2)));
__device__ __forceinline__ unsigned cvtpk_s(float lo,float hi){f32x2_t v={lo,hi};bf16x2_t b=__builtin_convertvector(v,bf16x2_t);return __builtin_bit_cast(unsigned,b);}
#define WAIT_BAR(N) asm volatile("s_waitcnt vmcnt(" #N ") lgkmcnt(0)\n\ts_barrier":::"memory")

__device__ __forceinline__ void qkt(f32x16&p0,f32x16&p1,const char*Kslot,const bf16x8*qr,int r32,int hi){
  const char*kb=Kslot+hi*1024+r32*16;
  #pragma unroll
  for(int d0=0;d0<4;++d0){
    const bf16x8 b0=*reinterpret_cast<const bf16x8*>(kb+d0*2048);
    const bf16x8 b1=*reinterpret_cast<const bf16x8*>(kb+d0*2048+512);
    p0=__builtin_amdgcn_mfma_f32_32x32x16_bf16(b0,qr[d0],p0,0,0,0);p1=__builtin_amdgcn_mfma_f32_32x32x16_bf16(b1,qr[d0],p1,0,0,0);}
}
typedef __attribute__((address_space(3))) const char* lds_cptr;
typedef short v4i16_t __attribute__((ext_vector_type(4)));
__device__ __forceinline__ void kload8(bf16x8*kf,lds_cptr kp){
  kf[0]=*(const __attribute__((address_space(3))) bf16x8*)(kp);      kf[1]=*(const __attribute__((address_space(3))) bf16x8*)(kp+512);
  kf[2]=*(const __attribute__((address_space(3))) bf16x8*)(kp+2048); kf[3]=*(const __attribute__((address_space(3))) bf16x8*)(kp+2560);
  kf[4]=*(const __attribute__((address_space(3))) bf16x8*)(kp+4096); kf[5]=*(const __attribute__((address_space(3))) bf16x8*)(kp+4608);
  kf[6]=*(const __attribute__((address_space(3))) bf16x8*)(kp+6144); kf[7]=*(const __attribute__((address_space(3))) bf16x8*)(kp+6656);
}
__device__ __forceinline__ void kload2(bf16x8*kf,lds_cptr kp,int j){ kf[2*j]=*(const __attribute__((address_space(3))) bf16x8*)(kp+j*2048); kf[2*j+1]=*(const __attribute__((address_space(3))) bf16x8*)(kp+j*2048+512); }
__device__ __forceinline__ s16x4 vtr(lds_cptr p){ return __builtin_bit_cast(s16x4,__builtin_amdgcn_ds_read_tr16_b64_v4i16((__attribute__((address_space(3))) v4i16_t*)p)); }
__device__ __forceinline__ float rowmax(const f32x16&p0,const f32x16&p1){
  float a=max3f(p0[0],p0[1],p1[0]),b=max3f(p0[2],p0[3],p1[1]);a=max3f(a,p1[2],p1[3]);
  #pragma unroll
  for(int r=4;r<16;r+=4){a=max3f(a,p0[r],p0[r+1]);b=max3f(b,p0[r+2],p0[r+3]);a=max3f(a,p1[r],p1[r+1]);b=max3f(b,p1[r+2],p1[r+3]);}
  const float m=max2f(a,b);
  auto rr=__builtin_amdgcn_permlane32_swap(__float_as_uint(m),__float_as_uint(m),false,false);
  return max2f(__uint_as_float(rr[0]),__uint_as_float(rr[1]));
}
__device__ __forceinline__ void pv(f32x16*o,int vb,bf16x8 pa0,bf16x8 pa1,bf16x8 pa2,bf16x8 pa3){
  #pragma unroll
  for(int d0=0;d0<2;++d0){s16x4 lo[4],hi[4];
    #pragma unroll
    for(int ks=0;ks<4;++ks){
      asm volatile("ds_read_b64_tr_b16 %0,%1 offset:%c2":"=&v"(lo[ks]):"v"(vb),"i"(d0*4096+ks*1024):"memory");
      asm volatile("ds_read_b64_tr_b16 %0,%1 offset:%c2":"=&v"(hi[ks]):"v"(vb),"i"(d0*4096+ks*1024+512):"memory");}
    asm volatile("s_waitcnt lgkmcnt(0)":::"memory");SBAR();
    #define PK(k) (bf16x8){lo[k][0],lo[k][1],lo[k][2],lo[k][3],hi[k][0],hi[k][1],hi[k][2],hi[k][3]}
    o[d0]=__builtin_amdgcn_mfma_f32_32x32x16_bf16(pa0,PK(0),o[d0],0,0,0);
    o[d0]=__builtin_amdgcn_mfma_f32_32x32x16_bf16(pa1,PK(1),o[d0],0,0,0);
    o[d0]=__builtin_amdgcn_mfma_f32_32x32x16_bf16(pa2,PK(2),o[d0],0,0,0);
    o[d0]=__builtin_amdgcn_mfma_f32_32x32x16_bf16(pa3,PK(3),o[d0],0,0,0);
    #undef PK
  }
}

#ifndef ATTN_STORE16
#define ATTN_STORE16(p,v) (*(u32x4*)(p)=(v))
#endif
template<int THRL> __device__ __forceinline__ void attn_unit(int b,int h,int qb,const bf16*Q,const bf16*__restrict__ K,const bf16*__restrict__ V,bf16*O,const float*__restrict__ cbias,bool store_en,char*shm){
  int tid_=threadIdx.x; asm volatile("":"+v"(tid_));
  const int tid=tid_,lane=tid&63,r32=lane&31,hi=lane>>5; const int wid=__builtin_amdgcn_readfirstlane(tid>>6);
  const long rowbase=(long)b*SEQ; const int q0=qb*QB;
  const bf16*Qw=Q+(rowbase+q0+wid*QBLK)*DM+h*D;
  const bf16*Kh=K+rowbase*DM+h*D,*Vh=V+rowbase*DM+h*D;
  const unsigned lds0=(unsigned)(uintptr_t)shm;
  float*wsf=(float*)(shm+LDS_WS)+wid*64;
  const bf16*ksrc=Kh+(long)lane*DM+wid*8;
  const bf16*vsrc=Vh+(long)(16*(wid&3)+(lane>>2))*DM+(wid>>2)*32+(lane&3)*8;
  const unsigned kdst=lds0+LDS_K+wid*1024, vdst=lds0+LDS_V+wid*1024;
  #define DMA_K(t,slot) glds16(ksrc+(long)(t)*KVBLK*DM,(unsigned)__builtin_amdgcn_readfirstlane(kdst+(slot)))
  #define DMA_V(t,slot) glds16(vsrc+(long)(t)*KVBLK*DM,(unsigned)__builtin_amdgcn_readfirstlane(vdst+(slot)))
  const int vb0=(int)(lds0+LDS_V)+((lane>>4)&1)*32+(lane&3)*8+(4*hi+((lane&15)>>2))*64;
  const char*Kbase=shm+LDS_K; bf16x8 kf[8];
  const lds_cptr shm3=(lds_cptr)shm; const lds_cptr kp0=shm3+LDS_K+hi*1024+r32*16; const lds_cptr vp0=shm3+LDS_V+((lane>>4)&1)*32+(lane&3)*8+(4*hi+((lane&15)>>2))*64;
  const int NT=(q0+QB)/KVBLK;
  typedef float f32x4v __attribute__((ext_vector_type(4)));
  __attribute__((address_space(3))) float* const blds=(__attribute__((address_space(3))) float*)((__attribute__((address_space(3))) char*)shm+LDS_BIAS);
  { const float* cb=cbias+((long)b*NHEAD+h)*SEQ; const int nk=q0+QB;
    for(int i=tid*4;i<nk;i+=2048){ const f32x4v v=*(const f32x4v*)(cb+i); *(__attribute__((address_space(3))) f32x4v*)(blds+i)=v; } }
  #define BINIT(C0,C1,t) do{ const __attribute__((address_space(3))) float* bp_=blds+64*(t)+4*hi; \
     _Pragma("unroll") for(int g_=0;g_<4;++g_){ const f32x4v b0_=*(const __attribute__((address_space(3))) f32x4v*)(bp_+8*g_); const f32x4v b1_=*(const __attribute__((address_space(3))) f32x4v*)(bp_+32+8*g_); \
       _Pragma("unroll") for(int i_=0;i_<4;++i_){ C0[4*g_+i_]=b0_[i_]-mhat; C1[4*g_+i_]=b1_[i_]-mhat; } } }while(0)
  DMA_K(0,0);DMA_V(0,0);DMA_K(1,SLOTB);
  bf16x8 qr[4];
  #pragma unroll
  for(int d0=0;d0<4;++d0)qr[d0]=*reinterpret_cast<const bf16x8*>(&Qw[(long)r32*DM+d0*16+hi*8]);
  float mhat=0.f,l_reg=0.f;f32x16 o[2];o[0]=f32x16{};o[1]=f32x16{};
  const int qrel=wid*QBLK+r32;
  #define CMASK(P0,P1,t) do{int jb_=(t)-(NT-4); if(jb_>=0)cmask(P0,P1,jb_,qrel,hi);}while(0)
  bool resc=false;
  #define START(P0,P1) do{ const float rm=rowmax(P0,P1); resc=false; \
    { const float dl=rm; mhat=fadd_s(mhat,dl); \
      _Pragma("unroll") for(int r=0;r<16;++r){P0[r]=fsub_s(P0[r],dl);P1[r]=fsub_s(P1[r],dl);} \
      } \
    _Pragma("unroll") for(int r=0;r<16;++r)P0[r]=__builtin_amdgcn_exp2f(P0[r]); }while(0)
  #define RESC() do{ if(resc){ asm volatile("s_waitcnt lgkmcnt(0)":::"memory"); \
      _Pragma("unroll") for(int d_=0;d_<2;++d_) _Pragma("unroll") for(int r=0;r<16;++r)o[d_][r]*=wsf[crow(r,hi)]; } }while(0)
  f32x16 pA0,pA1,pB0,pB1;
  int sl_prev=0,sl_cur=0,sl_next=SLOTB;
  #define ROT() do{sl_prev=sl_cur;sl_cur=sl_next;sl_next=(sl_next==(NSLOT-1)*SLOTB)?0:sl_next+SLOTB;}while(0)
  DMA_K(2,2*SLOTB);
  WAIT_BAR(3);
  BINIT(pA0,pA1,0); qkt(pA0,pA1,Kbase,qr,r32,hi);asm volatile("s_nop 15\n\ts_nop 7":"+v"(pA0),"+v"(pA1));CMASK(pA0,pA1,0);
  START(pA0,pA1);
  _Pragma("unroll") for(int r=0;r<16;++r)pA1[r]=__builtin_amdgcn_exp2f(pA1[r]);
  WAIT_BAR(0);
  DMA_K(3,0);DMA_V(1,SLOTB);
  ROT();
  kload8(kf,kp0+sl_cur);
  WAIT_BAR(2);
  s16x4 vlo[8],vhi[8]; u32x4 pw0,pw1,pw2,pw3;
  #define PKW(P,B) cvtpk_s(P[B],P[B+1])
  #define PAF(k) __builtin_bit_cast(bf16x8,pw##k)
  #define VFR(i) (bf16x8){vlo[i][0],vlo[i][1],vlo[i][2],vlo[i][3],vhi[i][0],vhi[i][1],vhi[i][2],vhi[i][3]}
  #define PIN(x) asm volatile("":"+v"(x))
  #define MX3(a,b,c) __builtin_fmaxf(__builtin_fmaxf((a),(b)),(c))
  #define GAPA(MF,A0,A1,A2,A3,W0,W1,PW) do{ MF; sacc+=A0; sacc+=A1; sacc+=A2; sacc+=A3; PIN(sacc); W0; W1; PIN(PW); SBAR(); }while(0)
  #define EX(v) __builtin_amdgcn_exp2f(v)
  #define GAPB(MF,X,B) do{ MF; X[B]=EX(X[B]); X[B+1]=EX(X[B+1]); X[B+2]=EX(X[B+2]); X[B+3]=EX(X[B+3]); PIN(X); SBAR(); }while(0)
  #define VRD(i) do{ vlo[i]=vtr(vp_+(((i)>>2)*4096+((i)&3)*1024)); vhi[i]=vtr(vp_+(((i)>>2)*4096+((i)&3)*1024+512)); }while(0)
  #define KRD(G,j) do{ if(G){ kload2(kf,kp0+sl_next,j); SBAR(); } }while(0)
  #define STEP(C0,C1,P0,P1,t,GK,GV,GL) do{ SBAR(); BINIT(C0,C1,t); SBAR(); \
    const lds_cptr vp_=vp0+sl_prev; \
    VRD(0); SBAR(); float sacc=(P0[0]+P0[1]); \
    GAPA(C0=__builtin_amdgcn_mfma_f32_32x32x16_bf16(kf[0],qr[0],C0,0,0,0), P0[2],P0[3],P0[4],P0[5],     pw0[0]=PKW(P0,0), pw0[1]=PKW(P0,2), pw0); \
    VRD(4); SBAR(); GAPA(C1=__builtin_amdgcn_mfma_f32_32x32x16_bf16(kf[1],qr[0],C1,0,0,0), P0[6],P0[7],P0[8],P0[9],     pw0[2]=PKW(P0,4), pw0[3]=PKW(P0,6), pw0); \
    VRD(1); SBAR(); GAPA(C0=__builtin_amdgcn_mfma_f32_32x32x16_bf16(kf[2],qr[1],C0,0,0,0),   P0[10],P0[11],P0[12],P0[13], pw1[0]=PKW(P0,8), pw1[1]=PKW(P0,10), pw1); \
    VRD(5); SBAR(); GAPA(C1=__builtin_amdgcn_mfma_f32_32x32x16_bf16(kf[3],qr[1],C1,0,0,0),   P0[14],P0[15],P1[0],P1[1],   pw1[2]=PKW(P0,12),pw1[3]=PKW(P0,14), pw1); \
    VRD(2); SBAR(); GAPA(C0=__builtin_amdgcn_mfma_f32_32x32x16_bf16(kf[4],qr[2],C0,0,0,0),   P1[2],P1[3],P1[4],P1[5],     pw2[0]=PKW(P1,0), pw2[1]=PKW(P1,2), pw2); \
    VRD(6); SBAR(); GAPA(C1=__builtin_amdgcn_mfma_f32_32x32x16_bf16(kf[5],qr[2],C1,0,0,0),   P1[6],P1[7],P1[8],P1[9],     pw2[2]=PKW(P1,4), pw2[3]=PKW(P1,6), pw2); \
    VRD(3); SBAR(); GAPA(C0=__builtin_amdgcn_mfma_f32_32x32x16_bf16(kf[6],qr[3],C0,0,0,0),   P1[10],P1[11],P1[12],P1[13], pw3[0]=PKW(P1,8), pw3[1]=PKW(P1,10), pw3); \
    VRD(7); SBAR(); GAPA(C1=__builtin_amdgcn_mfma_f32_32x32x16_bf16(kf[7],qr[3],C1,0,0,0),   P1[14],P1[15],0.f,0.f,       pw3[2]=PKW(P1,12),pw3[3]=PKW(P1,14), pw3); \
    l_reg+=sacc; \
    if(GK){DMA_K((t)+3,sl_cur);} if(GV){DMA_V((t)+1,sl_next);} \
    CMASK(C0,C1,t); \
    { float a=MX3(C0[0],C0[1],C1[0]),b=MX3(C0[2],C0[3],C1[1]); a=MX3(a,C1[2],C1[3]); \
      _Pragma("unroll") for(int r=4;r<16;r+=4){a=MX3(a,C0[r],C0[r+1]);b=MX3(b,C0[r+2],C0[r+3]);a=MX3(a,C1[r],C1[r+1]);b=MX3(b,C1[r+2],C1[r+3]);} \
      float rm=__builtin_fmaxf(a,b); { auto rr=__builtin_amdgcn_permlane32_swap(__float_as_uint(rm),__float_as_uint(rm),false,false); rm=__builtin_fmaxf(__uint_as_float(rr[0]),__uint_as_float(rr[1])); } \
      resc=false; \
      if(__builtin_expect(__any(rm>(float)THRL),0)){ const float dl=__builtin_fmaxf(rm,0.f); mhat+=dl; \
        _Pragma("unroll") for(int r=0;r<16;++r){C0[r]-=dl;C1[r]-=dl;} \
        const float f=__builtin_amdgcn_exp2f(-dl); l_reg*=f; if(hi==0)wsf[r32]=f; resc=true; } } \
    SBAR(); \
    GAPB(o[0]=__builtin_amdgcn_mfma_f32_32x32x16_bf16(PAF(0),VFR(0),o[0],0,0,0), C0,0); \
    GAPB(o[1]=__builtin_amdgcn_mfma_f32_32x32x16_bf16(PAF(0),VFR(4),o[1],0,0,0), C0,4); \
    KRD(GL,0); GAPB(o[0]=__builtin_amdgcn_mfma_f32_32x32x16_bf16(PAF(1),VFR(1),o[0],0,0,0), C0,8); \
    KRD(GL,1); GAPB(o[1]=__builtin_amdgcn_mfma_f32_32x32x16_bf16(PAF(1),VFR(5),o[1],0,0,0), C0,12); \
    KRD(GL,2); GAPB(o[0]=__builtin_amdgcn_mfma_f32_32x32x16_bf16(PAF(2),VFR(2),o[0],0,0,0), C1,0); \
    KRD(GL,3); GAPB(o[1]=__builtin_amdgcn_mfma_f32_32x32x16_bf16(PAF(2),VFR(6),o[1],0,0,0), C1,4); \
    GAPB(o[0]=__builtin_amdgcn_mfma_f32_32x32x16_bf16(PAF(3),VFR(3),o[0],0,0,0), C1,8); \
    GAPB(o[1]=__builtin_amdgcn_mfma_f32_32x32x16_bf16(PAF(3),VFR(7),o[1],0,0,0), C1,12); \
    }while(0)
  int t=1;
  #undef CMASK
  #define CMASK(P0,P1,t) do{}while(0)
  for(;t+5<NT;t+=2){
    STEP(pB0,pB1,pA0,pA1,t,true,true,true);     WAIT_BAR(2); RESC(); ROT();
    STEP(pA0,pA1,pB0,pB1,t+1,true,true,true);   WAIT_BAR(2); RESC(); ROT();
  }
  #undef CMASK
  #define CMASK(P0,P1,t) do{int jb_=(t)-(NT-4); if(jb_>=0)cmask(P0,P1,jb_,qrel,hi);}while(0)
  #define ENDW(tt) do{ if((tt)+3<NT){WAIT_BAR(2);} else if((tt)+2<NT){WAIT_BAR(1);} else {WAIT_BAR(0);} }while(0)
  for(;t+1<NT;t+=2){
    STEP(pB0,pB1,pA0,pA1,t,(t+3<NT),(t+1<NT),(t+1<NT));       ENDW(t);   RESC(); ROT();
    STEP(pA0,pA1,pB0,pB1,t+1,(t+4<NT),(t+2<NT),(t+2<NT));     ENDW(t+1); RESC(); ROT();
  }
  STEP(pB0,pB1,pA0,pA1,NT-1,false,false,false); RESC();
  { float sacc=pB0[0]+pB0[1]; _Pragma("unroll") for(int r=2;r<16;++r)sacc+=pB0[r]; _Pragma("unroll") for(int r=0;r<16;++r)sacc+=pB1[r]; l_reg+=sacc;
    pw0=(u32x4){PKW(pB0,0),PKW(pB0,2),PKW(pB0,4),PKW(pB0,6)};pw1=(u32x4){PKW(pB0,8),PKW(pB0,10),PKW(pB0,12),PKW(pB0,14)};pw2=(u32x4){PKW(pB1,0),PKW(pB1,2),PKW(pB1,4),PKW(pB1,6)};pw3=(u32x4){PKW(pB1,8),PKW(pB1,10),PKW(pB1,12),PKW(pB1,14)};
    SBAR(); pv(o,vb0+sl_cur,PAF(0),PAF(1),PAF(2),PAF(3)); }
  #undef PKW
  #undef PAF
  #undef VFR
  #undef PIN
  #undef MX3
  #undef GAPA
  #undef GAPB
  #undef EX
  #undef VRD
  #undef KRD
  #undef STEP
  #undef ENDW
  {auto rr=__builtin_amdgcn_permlane32_swap(__float_as_uint(l_reg),__float_as_uint(l_reg),false,false);l_reg=__uint_as_float(rr[0])+__uint_as_float(rr[1]);}
  if(hi==0)wsf[32+r32]=l_reg;asm volatile("s_waitcnt lgkmcnt(0)":::"memory");
  float rli[16];
  #pragma unroll
  for(int r=0;r<16;++r)rli[r]=__builtin_amdgcn_rcpf(wsf[32+crow(r,hi)]);
  bf16*Ow=O+(rowbase+q0+wid*QBLK)*DM+h*D;
  { bf16*stg=(bf16*)(shm+LDS_OST)+wid*2048;
    #pragma unroll
    for(int r=0;r<16;++r){const int orow=crow(r,hi);
      #pragma unroll
      for(int d0=0;d0<2;++d0)stg[orow*64+d0*32+r32]=__float2bfloat16(o[d0][r]*rli[r]);}
    asm volatile("s_waitcnt lgkmcnt(0)":::"memory");
    #pragma unroll
    for(int i=0;i<4;++i){const int row=i*8+(lane>>3),ch=lane&7; const u32x4 v=*(const u32x4*)(stg+row*64+ch*8); if(store_en)ATTN_STORE16(Ow+(long)row*DM+ch*8,v);} }
  asm volatile("s_waitcnt lgkmcnt(0)\n\ts_barrier":::"memory");
  #undef DMA_K
  #undef DMA_V
  #undef BINIT
  #undef CMASK
  #undef START
  #undef RESC
  #undef ROT
}
constexpr int ATTN_LDS_BYTES=LDS_BYTES;
#undef SBAR
#undef WAIT_BAR
}
#define LAS __attribute__((address_space(3)))
typedef unsigned short hb16;
typedef unsigned v4u __attribute__((ext_vector_type(4)));
typedef unsigned v2u __attribute__((ext_vector_type(2)));
typedef float f32x4 __attribute__((ext_vector_type(4)));
typedef float f32x16 __attribute__((ext_vector_type(16)));
typedef short bf16x8 __attribute__((ext_vector_type(8)));
typedef short s16x4 __attribute__((ext_vector_type(4)));

constexpr int NB = 4, SEQ = 4096, T = NB * SEQ, DM = 1024, DFF = 2816, QP = 4864, FP = 5632, NLAYER = 2;
constexpr float LOG2E = 1.4426950408889634f;
constexpr float C2 = 0.125f * LOG2E;
constexpr float ALPHA = 1.4142135623730951f;
constexpr float LN_EPS = 1e-5f;
constexpr int COL_QA = 0, COL_QB = 512, COL_QC = 1024, COL_QD = 1536, COL_KA = 2048, COL_VA = 2176, COL_KB = 2304, COL_VB = 2816, COL_KC = 3328, COL_VC = 3392,
              COL_IQ = 3456, COL_IK = 3712, COL_KD = 3776, COL_VD = 4288, COL_IW = 4800, COL_DF = 4804;
constexpr int COL_GSCR = 2048, COL_MRG = 3072;
constexpr size_t MiB = 1u << 20;
constexpr size_t WS_CTL = 0, CTL_ZERO_BYTES = 16384;
constexpr size_t WS_W = 1 * MiB;
constexpr size_t W_IN = 0, W_G = W_IN + (size_t)QP * DM * 2, W_B = W_G + (size_t)4096 * DM * 2, W_O = W_B + (size_t)4 * 1024 * 512 * 2, W_UF = W_O + (size_t)DM * DM * 2, W_D = W_UF + (size_t)FP * DM * 2, W_END = W_D + (size_t)DM * DFF * 2;
static_assert(W_END == 40 * MiB, "weights");
constexpr size_t WS_XB = 41 * MiB, WS_BIG = 73 * MiB, WS_SIDE = 249 * MiB, WS_CB = 250 * MiB, WS_END = 256 * MiB;
static_assert(WS_BIG + (size_t)T * FP * 2 <= WS_SIDE && WS_BIG + (size_t)T * QP * 2 <= WS_SIDE, "big");
constexpr size_t DO_IDX = 0, DO_PU1 = 8 * MiB, DO_PU2 = 24 * MiB, DO_PML1 = 40 * MiB, DO_PML2 = 41 * MiB;
constexpr int LDS_BYTES = 147456;
constexpr int NWAVES = 8;

struct Args { const float* in[17]; float* out; unsigned char* ws; int ph_lo, ph_hi; };
static_assert(sizeof(Args) == 17 * 8 + 8 + 8 + 8, "Args has no padding");
struct Frame {
    LAS unsigned char* lds; int tid, lane, wave, vcu, G;
    float* out; unsigned char* ws;
    __device__ __forceinline__ hb16* Win_t() const { return (hb16*)(ws + WS_W + W_IN); }
    __device__ __forceinline__ hb16* Wg_t() const { return (hb16*)(ws + WS_W + W_G); }
    __device__ __forceinline__ hb16* Wb_t() const { return (hb16*)(ws + WS_W + W_B); }
    __device__ __forceinline__ hb16* Wo_t() const { return (hb16*)(ws + WS_W + W_O); }
    __device__ __forceinline__ hb16* Wuf_t() const { return (hb16*)(ws + WS_W + W_UF); }
    __device__ __forceinline__ hb16* Wd_t() const { return (hb16*)(ws + WS_W + W_D); }
    __device__ __forceinline__ hb16* XB() const { return (hb16*)(ws + WS_XB); }
    __device__ __forceinline__ hb16* BIG() const { return (hb16*)(ws + WS_BIG); }
    __device__ __forceinline__ float* side() const { return (float*)(ws + WS_SIDE); }
    __device__ __forceinline__ float* cb() const { return (float*)(ws + WS_CB); }
    __device__ __forceinline__ unsigned short* idx() const { return (unsigned short*)((unsigned char*)out + DO_IDX); }
    __device__ __forceinline__ hb16* pu1() const { return (hb16*)((unsigned char*)out + DO_PU1); }
    __device__ __forceinline__ hb16* pu2() const { return (hb16*)((unsigned char*)out + DO_PU2); }
    __device__ __forceinline__ float* pml1() const { return (float*)((unsigned char*)out + DO_PML1); }
    __device__ __forceinline__ float* pml2() const { return (float*)((unsigned char*)out + DO_PML2); }
};

__device__ __forceinline__ unsigned f2bf(float f) { unsigned u = __builtin_bit_cast(unsigned, f); return (u + 0x7fffu + ((u >> 16) & 1u)) >> 16; }
__device__ __forceinline__ unsigned pk2(float lo, float hi) { return f2bf(lo) | (f2bf(hi) << 16); }
__device__ __forceinline__ float bfl(unsigned w) { return __uint_as_float(w << 16); }
__device__ __forceinline__ float bfh(unsigned w) { return __uint_as_float(w & 0xffff0000u); }
__device__ __forceinline__ float bf1(hb16 w) { return __uint_as_float((unsigned)w << 16); }
__device__ __forceinline__ float wave_sum(float v) {
#pragma unroll
    for (int o = 1; o < 64; o <<= 1) v += __shfl_xor(v, o);
    return v;
}
__device__ __forceinline__ int crow(int r, int hi) { return (r & 3) + 8 * (r >> 2) + 4 * hi; }
#define LDS_WAIT() asm volatile("s_waitcnt lgkmcnt(0)" ::: "memory")
#define WBAR() __builtin_amdgcn_wave_barrier()
__device__ __forceinline__ s16x4 vtr(const LAS unsigned char* p) { typedef short v4i16_t __attribute__((ext_vector_type(4))); return __builtin_bit_cast(s16x4, __builtin_amdgcn_ds_read_tr16_b64_v4i16((LAS v4i16_t*)p)); }
__device__ __forceinline__ bf16x8 cat8(s16x4 lo, s16x4 hi) { return (bf16x8){lo[0], lo[1], lo[2], lo[3], hi[0], hi[1], hi[2], hi[3]}; }

__device__ __forceinline__ void tr_item(const float* W, int srcN, int K, hb16* WT, int nblk, LAS float* scr, int item, int lane) {
    const int kb = item / nblk, nb = item % nblk, k0 = 64 * kb, n0 = 32 * nb;
#pragma unroll 8
    for (int i = 0; i < 32; ++i) { const int kk = 2 * i + (lane >> 5); scr[kk * 33 + (lane & 31)] = W[(size_t)(k0 + kk) * srcN + n0 + (lane & 31)]; }
    LDS_WAIT(); asm volatile("" ::: "memory");
    const int c = lane & 7;
#pragma unroll
    for (int j = 0; j < 4; ++j) { const int n = (lane >> 3) + 8 * j; const LAS float* s = scr + (8 * c) * 33 + n;
        v4u o; o.x = pk2(s[0 * 33], s[1 * 33]); o.y = pk2(s[2 * 33], s[3 * 33]); o.z = pk2(s[4 * 33], s[5 * 33]); o.w = pk2(s[6 * 33], s[7 * 33]);
        *(v4u*)(WT + (size_t)(n0 + n) * K + k0 + 8 * c) = o; }
    LDS_WAIT(); asm volatile("" ::: "memory");
}
__device__ __forceinline__ int win_src(int n, float& sc) {
    sc = 1.f;
    if (n < 2048) { sc = C2; const int br = n >> 9, o = n & 511; return (br == 0 ? 0 : br == 1 ? 768 : br == 2 ? 2304 : 3268) + o; }
    if (n < 2176) return 512 + (n - 2048);
    if (n < 2304) return 640 + (n - 2176);
    if (n < 2816) return 1280 + (n - 2304);
    if (n < 3328) return 1792 + (n - 2816);
    if (n < 3392) return 2816 + (n - 3328);
    if (n < 3456) return 2880 + (n - 3392);
    if (n < 3712) { sc = 0.125f; return 2944 + (n - 3456); }
    if (n < 3776) return 3200 + (n - 3712);
    if (n < 4288) return 3780 + (n - 3776);
    if (n < 4800) return 4292 + (n - 4288);
    if (n < 4804) return 3264 + (n - 4800);
    if (n < 4812) return 4804 + (n - 4804);
    sc = 0.f; return 0;
}
__device__ __forceinline__ void tr_item_win(const float* W, hb16* WT, LAS float* scr, int item, int lane) {
    constexpr int nblk = QP / 32, K = DM, srcN = 4812;
    const int kb = item / nblk, nb = item % nblk, k0 = 64 * kb, n0 = 32 * nb;
    float sc; const int sn = win_src(n0 + (lane & 31), sc);
#pragma unroll 8
    for (int i = 0; i < 32; ++i) { const int kk = 2 * i + (lane >> 5); scr[kk * 33 + (lane & 31)] = W[(size_t)(k0 + kk) * srcN + sn] * sc; }
    LDS_WAIT(); asm volatile("" ::: "memory");
    const int c = lane & 7;
#pragma unroll
    for (int j = 0; j < 4; ++j) { const int n = (lane >> 3) + 8 * j; const LAS float* s = scr + (8 * c) * 33 + n;
        v4u o; o.x = pk2(s[0 * 33], s[1 * 33]); o.y = pk2(s[2 * 33], s[3 * 33]); o.z = pk2(s[4 * 33], s[5 * 33]); o.w = pk2(s[6 * 33], s[7 * 33]);
        *(v4u*)(WT + (size_t)(n0 + n) * K + k0 + 8 * c) = o; }
    LDS_WAIT(); asm volatile("" ::: "memory");
}
__device__ __forceinline__ void convert_weights(Frame& F, const Args& A, int l) {
    LAS float* scr = (LAS float*)(F.lds + F.wave * 16384);
    const int gw = F.vcu * NWAVES + F.wave, NGW = F.G * NWAVES;
    constexpr int I_IN = 16 * (QP / 32), I_G = 16 * 128, I_B1 = 8 * 32, I_O = 16 * 32, I_U = 16 * 88, I_D = 44 * 32;
    constexpr int NITEMS = I_IN + I_G + 4 * I_B1 + I_O + 2 * I_U + I_D;
    const float* w_in = A.in[1] + (size_t)l * DM * 4812; const float* w_br = A.in[4] + (size_t)l * 4 * 512 * DM; const float* w_g = A.in[5] + (size_t)l * DM * 4096;
    const float* w_o = A.in[7] + (size_t)l * DM * DM; const float* w_up = A.in[10] + (size_t)l * DM * DFF; const float* w_fg = A.in[11] + (size_t)l * DM * DFF; const float* w_dn = A.in[14] + (size_t)l * DFF * DM;
    for (int it = gw; it < NITEMS; it += NGW) {
        int r = it;
        if (r < I_IN) { tr_item_win(w_in, F.Win_t(), scr, r, F.lane); continue; } r -= I_IN;
        if (r < I_G) { tr_item(w_g, 4096, DM, F.Wg_t(), 128, scr, r, F.lane); continue; } r -= I_G;
        if (r < 4 * I_B1) { const int n = r / I_B1; tr_item(w_br + (size_t)n * 512 * DM, DM, 512, F.Wb_t() + (size_t)n * 1024 * 512, 32, scr, r % I_B1, F.lane); continue; } r -= 4 * I_B1;
        if (r < I_O) { tr_item(w_o, DM, DM, F.Wo_t(), 32, scr, r, F.lane); continue; } r -= I_O;
        if (r < I_U) { tr_item(w_up, DFF, DM, F.Wuf_t(), 88, scr, r, F.lane); continue; } r -= I_U;
        if (r < I_U) { tr_item(w_fg, DFF, DM, F.Wuf_t() + (size_t)DFF * DM, 88, scr, r, F.lane); continue; } r -= I_U;
        tr_item(w_dn, DM, DFF, F.Wd_t(), 32, scr, r, F.lane);
    }
}
__device__ __forceinline__ void x_to_bf16(Frame& F, const float* x) {
    const size_t n8 = (size_t)T * DM / 8; hb16* XBp = F.XB();
    for (size_t i = (size_t)blockIdx.x * 512 + F.tid; i < n8; i += (size_t)F.G * 512) {
        const f32x4 a = *(const f32x4*)(x + i * 8), b = *(const f32x4*)(x + i * 8 + 4);
        v4u o; o.x = pk2(a[0], a[1]); o.y = pk2(a[2], a[3]); o.z = pk2(b[0], b[1]); o.w = pk2(b[2], b[3]);
        *(v4u*)(XBp + i * 8) = o; }
}
__device__ __forceinline__ void ln_phase(Frame& F, const float* gam, const float* bet, bool last) {
    const int gw = F.vcu * NWAVES + F.wave, NGW = F.G * NWAVES;
    f32x4 gv[4], bv[4];
#pragma unroll
    for (int j = 0; j < 4; ++j) { gv[j] = *(const f32x4*)(gam + 4 * F.lane + 256 * j); bv[j] = *(const f32x4*)(bet + 4 * F.lane + 256 * j); }
    for (int m = gw; m < T; m += NGW) {
        float* zr = F.out + (size_t)m * DM + 4 * F.lane;
        f32x4 v[4]; float s = 0.f;
#pragma unroll
        for (int j = 0; j < 4; ++j) { v[j] = *(const f32x4*)(zr + 256 * j); s += (v[j][0] + v[j][1]) + (v[j][2] + v[j][3]); }
        const float mean = wave_sum(s) * (1.f / DM); float s2 = 0.f;
#pragma unroll
        for (int j = 0; j < 4; ++j) { v[j] = v[j] - mean; s2 += (v[j][0] * v[j][0] + v[j][1] * v[j][1]) + (v[j][2] * v[j][2] + v[j][3] * v[j][3]); }
        const float rstd = 1.f / sqrtf(wave_sum(s2) * (1.f / DM) + LN_EPS);
        hb16* xr = F.XB() + (size_t)m * DM + 4 * F.lane;
#pragma unroll
        for (int j = 0; j < 4; ++j) { const f32x4 y = v[j] * rstd * gv[j] + bv[j];
            if (last) *(f32x4*)(zr + 256 * j) = y;
            else { v2u o; o.x = pk2(y[0], y[1]); o.y = pk2(y[2], y[3]); *(v2u*)(xr + 256 * j) = o; } }
    }
}
__device__ __forceinline__ float gelu_t(float x) { const float u = 0.7978845608028654f * (x + 0.044715f * x * x * x); return x * __builtin_amdgcn_rcpf(1.f + __builtin_amdgcn_exp2f(-2.f * LOG2E * u)); }
__device__ __forceinline__ void ffn_elem_phase(Frame& F, const float* cw, const float* cbias) {
    const int gw = F.vcu * NWAVES + F.wave, NGW = F.G * NWAVES;
    hb16* BIGp = F.BIG();
    for (int task = gw; task < (T / 16) * 11; task += NGW) {
        const int rc = task / 11, cgp = task % 11, r0 = 16 * rc, c = 256 * cgp + 4 * F.lane;
        const f32x4 w0 = *(const f32x4*)(cw + c), w1 = *(const f32x4*)(cw + DFF + c), w2 = *(const f32x4*)(cw + 2 * DFF + c), b = *(const f32x4*)(cbias + c);
        const bool seq0 = (r0 % SEQ) == 0;
        f32x4 am2 = {0.f, 0.f, 0.f, 0.f}, am1 = {0.f, 0.f, 0.f, 0.f};
        if (!seq0) { const v2u p2 = *(const v2u*)(BIGp + (size_t)(r0 - 2) * FP + c), p1 = *(const v2u*)(BIGp + (size_t)(r0 - 1) * FP + c);
            am2 = (f32x4){bfl(p2.x), bfh(p2.x), bfl(p2.y), bfh(p2.y)}; am1 = (f32x4){bfl(p1.x), bfh(p1.x), bfl(p1.y), bfh(p1.y)}; }
#pragma unroll 4
        for (int i = 0; i < 16; ++i) {
            hb16* rp = BIGp + (size_t)(r0 + i) * FP + c;
            const v2u pa = *(const v2u*)rp, pg = *(const v2u*)(rp + DFF);
            const f32x4 a0 = {bfl(pa.x), bfh(pa.x), bfl(pa.y), bfh(pa.y)}, g = {bfl(pg.x), bfh(pg.x), bfl(pg.y), bfh(pg.y)};
            const f32x4 v = b + w0 * am2 + w1 * am1 + w2 * a0;
            v2u o; o.x = pk2(gelu_t(v[0]) * g[0], gelu_t(v[1]) * g[1]); o.y = pk2(gelu_t(v[2]) * g[2], gelu_t(v[3]) * g[3]);
            *(v2u*)(rp + DFF) = o; am2 = am1; am1 = a0; }
    }
}
__device__ __forceinline__ void cumsum_task(Frame& F, const float* b_forget_l, int bh) {
    const int b = bh >> 3, h = bh & 7; const float bf = b_forget_l[h]; const float* sidep = F.side();
    float v[8]; float s = 0.f;
#pragma unroll
    for (int i = 0; i < 8; ++i) { const int t = 8 * F.tid + i; const float f = sidep[((size_t)b * SEQ + t) * 16 + 4 + h] + bf;
        const float ls = fminf(f, 0.f) - log1pf(__expf(-fabsf(f))); s += ls; v[i] = s; }
    float incl = s;
#pragma unroll
    for (int o = 1; o < 64; o <<= 1) { const float n = __shfl_up(incl, o); if (F.lane >= o) incl += n; }
    LAS float* wt = (LAS float*)F.lds;
    if (F.lane == 63) wt[F.wave] = incl;
    __syncthreads();
    float off = 0.f;
#pragma unroll
    for (int w = 0; w < 8; ++w) { const float x = wt[w]; if (w < F.wave) off += x; }
    const float base = off + incl - s;
    float* o = F.cb() + (size_t)bh * SEQ + 8 * F.tid;
    f32x4 o0, o1;
#pragma unroll
    for (int i = 0; i < 4; ++i) { o0[i] = -(base + v[i]) * LOG2E; o1[i] = -(base + v[4 + i]) * LOG2E; }
    *(f32x4*)o = o0; *(f32x4*)(o + 4) = o1;
    __syncthreads();
}
__device__ __forceinline__ f32x16 band_scores(const hb16* __restrict__ kp, const bf16x8 (&qr)[4], long tok0, int stride, int i0, int j, float slope2, int maxd, int r32, int hi) {
    const int kb = i0 - 128 + 32 * j;
    const hb16* krow = kp + (tok0 + (long)stride * (kb + r32)) * QP + 8 * hi;
    f32x16 acc = {};
#pragma unroll
    for (int s = 0; s < 4; ++s) { const bf16x8 kf = *(const bf16x8*)(krow + 16 * s); acc = __builtin_amdgcn_mfma_f32_32x32x16_bf16(kf, qr[s], acc, 0, 0, 0); }
    const int d0 = 128 - 32 * j + r32 - 4 * hi;
#pragma unroll
    for (int r = 0; r < 16; ++r) { const int dist = d0 - ((r & 3) + 8 * (r >> 2)); const float v = acc[r] - slope2 * (float)dist; acc[r] = (dist >= 0 && dist <= maxd) ? v : -INFINITY; }
    return acc;
}
template <int MODE> __device__ __forceinline__ void banded_unit(
    const hb16* __restrict__ qp, const hb16* __restrict__ kp, const hb16* __restrict__ vp, long tok0, int stride, int i0, float slope2, int maxd, float sink2, bool has_sink,
    hb16* op, hb16* pu, float* pml, const hb16* pu1, const float* pml1, const hb16* pu2, const float* pml2, LAS unsigned char* wl, int lane) {
    const int r32 = lane & 31, hi = lane >> 5;
    const hb16* qrow = qp + (tok0 + (long)stride * (i0 + r32)) * QP;
    bf16x8 qr[4];
#pragma unroll
    for (int s = 0; s < 4; ++s) qr[s] = *(const bf16x8*)(qrow + 16 * s + 8 * hi);
    const int jlo = (i0 >= 128) ? 0 : (128 - i0) / 32;
    float m = -INFINITY;
#pragma unroll 1
    for (int j = jlo; j < 5; ++j) {
        const f32x16 S = band_scores(kp, qr, tok0, stride, i0, j, slope2, maxd, r32, hi);
#pragma unroll
        for (int r = 0; r < 16; ++r) m = fmaxf(m, S[r]);
    }
    m = fmaxf(m, __shfl_xor(m, 32));
    if (has_sink) m = fmaxf(m, sink2);
    float l = 0.f;
    f32x16 o[2]; o[0] = f32x16{}; o[1] = f32x16{};
    const LAS unsigned char* vrd = wl + (4 * hi + ((lane & 15) >> 2)) * 144 + (16 * ((lane >> 4) & 1) + 4 * (lane & 3)) * 2;
#pragma unroll 1
    for (int j = jlo; j < 5; ++j) {
        const int kb = i0 - 128 + 32 * j;
        v4u vx[4];
#pragma unroll
        for (int p = 0; p < 4; ++p) { const int row = (lane >> 3) + 8 * p, piece = lane & 7; vx[p] = *(const v4u*)(vp + (tok0 + (long)stride * (kb + row)) * QP + piece * 8); }
        f32x16 S = band_scores(kp, qr, tok0, stride, i0, j, slope2, maxd, r32, hi);
#pragma unroll
        for (int r = 0; r < 16; ++r) { const float p = __builtin_amdgcn_exp2f(S[r] - m); S[r] = p; l += p; }
#pragma unroll
        for (int p = 0; p < 4; ++p) { const int row = (lane >> 3) + 8 * p, piece = lane & 7; *(LAS v4u*)(wl + row * 144 + piece * 16) = vx[p]; }
        WBAR();
#pragma unroll
        for (int s = 0; s < 2; ++s) {
            v4u pw; pw.x = pk2(S[8 * s + 0], S[8 * s + 1]); pw.y = pk2(S[8 * s + 2], S[8 * s + 3]); pw.z = pk2(S[8 * s + 4], S[8 * s + 5]); pw.w = pk2(S[8 * s + 6], S[8 * s + 7]);
            const bf16x8 pa = __builtin_bit_cast(bf16x8, pw);
#pragma unroll
            for (int db = 0; db < 2; ++db) { const s16x4 lo = vtr(vrd + 16 * s * 144 + db * 64), hh = vtr(vrd + (16 * s + 8) * 144 + db * 64);
                o[db] = __builtin_amdgcn_mfma_f32_32x32x16_bf16(pa, cat8(lo, hh), o[db], 0, 0, 0); }
        }
        WBAR();
        asm volatile("" ::: "memory");
    }
    l += __shfl_xor(l, 32);
    if (has_sink) l += __builtin_amdgcn_exp2f(sink2 - m);
    LAS float* wsf = (LAS float*)(wl + 4608);
    if (MODE == 0) {
        if (hi == 0) wsf[r32] = __builtin_amdgcn_rcpf(l);
        WBAR();
#pragma unroll
        for (int r = 0; r < 16; ++r) { const int q = crow(r, hi); const float inv = wsf[q]; hb16* orow = op + (tok0 + (long)stride * (i0 + q)) * QP;
            orow[r32] = (hb16)f2bf(o[0][r] * inv); orow[32 + r32] = (hb16)f2bf(o[1][r] * inv); }
        WBAR();
    } else if (MODE == 1) {
        if (hi == 0) { float* ml = pml + (tok0 + (long)stride * (i0 + r32)) * 16; ml[0] = m; ml[1] = l; }
#pragma unroll
        for (int r = 0; r < 16; ++r) { const int q = crow(r, hi); hb16* orow = pu + (tok0 + (long)stride * (i0 + q)) * 512;
            orow[r32] = (hb16)f2bf(o[0][r]); orow[32 + r32] = (hb16)f2bf(o[1][r]); }
    } else {
        const long tq = tok0 + (long)stride * (i0 + r32);
        const float m1 = pml1[tq * 16], l1 = pml1[tq * 16 + 1], m2 = pml2[tq * 16], l2 = pml2[tq * 16 + 1];
        const float M = fmaxf(m, fmaxf(m1, m2)); const float f0 = __builtin_amdgcn_exp2f(m - M), f1 = __builtin_amdgcn_exp2f(m1 - M), f2 = __builtin_amdgcn_exp2f(m2 - M);
        const float inv = 1.f / (f0 * l + f1 * l1 + f2 * l2);
        if (hi == 0) { wsf[r32] = f0 * inv; wsf[32 + r32] = f1 * inv; wsf[64 + r32] = f2 * inv; }
        WBAR();
#pragma unroll 4
        for (int r = 0; r < 16; ++r) { const int q = crow(r, hi); const long tk = tok0 + (long)stride * (i0 + q); const float w0 = wsf[q], w1 = wsf[32 + q], w2 = wsf[64 + q];
            const hb16* u1 = pu1 + tk * 512; const hb16* u2 = pu2 + tk * 512; hb16* orow = op + tk * QP;
            orow[r32] = (hb16)f2bf(w0 * o[0][r] + w1 * bf1(u1[r32]) + w2 * bf1(u2[r32]));
            orow[32 + r32] = (hb16)f2bf(w0 * o[1][r] + w1 * bf1(u1[32 + r32]) + w2 * bf1(u2[32 + r32])); }
        WBAR();
    }
}
__device__ __forceinline__ float slope_of(int branch, int h) { return exp2f(-(float)(3 * h + 1 + branch) * (1.f / 3.f)); }

__device__ __forceinline__ float dpp_f(float x, int which) {
    const int v = __float_as_int(x);
    return __int_as_float(which == 0 ? __builtin_amdgcn_mov_dpp(v, 0xB1, 0xF, 0xF, true) : __builtin_amdgcn_mov_dpp(v, 0x4E, 0xF, 0xF, true));
}
__device__ __forceinline__ int wave_isum(int x) {
    x += __builtin_amdgcn_mov_dpp(x, 0xB1, 0xF, 0xF, true);
    x += __builtin_amdgcn_mov_dpp(x, 0x4E, 0xF, 0xF, true);
    x += __builtin_amdgcn_mov_dpp(x, 0x141, 0xF, 0xF, true);
    x += __builtin_amdgcn_mov_dpp(x, 0x140, 0xF, 0xF, true);
    return __builtin_amdgcn_readlane(x, 0) + __builtin_amdgcn_readlane(x, 16) + __builtin_amdgcn_readlane(x, 32) + __builtin_amdgcn_readlane(x, 48);
}
__device__ __forceinline__ int wave_excl_scan(int x, int lane) {
    int incl = x;
#pragma unroll
    for (int o = 1; o < 64; o <<= 1) { const int n = __shfl_up(incl, o); if (lane >= o) incl += n; }
    return incl - x;
}
constexpr int SC_PITCH = 64 * 65 + 4;
__device__ __forceinline__ void indexer_step(Frame& F, int b, int sl) {
    const int lane = F.lane, wave = F.wave, r32 = lane & 31, hi = lane >> 5;
    const int t0 = 8 * sl; const long tokb = (long)b * SEQ;
    const int ntile = (t0 + 8 + 31) >> 5;
    const int qq = r32 >> 2, hh = r32 & 3;
    const hb16* QKV = F.BIG();
    const hb16* iqrow = QKV + (tokb + t0 + qq) * QP + COL_IQ + 64 * hh;
    bf16x8 qf[4];
#pragma unroll
    for (int s = 0; s < 4; ++s) qf[s] = *(const bf16x8*)(iqrow + 16 * s + 8 * hi);
    const float iw = F.side()[(tokb + t0 + qq) * 16 + hh];
    LAS float* sc = (LAS float*)F.lds;
    for (int tb = wave; tb < ntile; tb += 64) {
        bf16x8 kf[8][4];
#pragma unroll
        for (int g = 0; g < 8; ++g) { const int tile = tb + 8 * g;
            if (tile < ntile) { const hb16* krow = QKV + (tokb + 32 * tile + r32) * QP + COL_IK + 8 * hi;
#pragma unroll
                for (int s = 0; s < 4; ++s) kf[g][s] = *(const bf16x8*)(krow + 16 * s); } }
#pragma unroll
        for (int g = 0; g < 8; ++g) { const int tile = tb + 8 * g;
            if (tile < ntile) {
                f32x16 acc = {};
#pragma unroll
                for (int s = 0; s < 4; ++s) acc = __builtin_amdgcn_mfma_f32_32x32x16_bf16(kf[g][s], qf[s], acc, 0, 0, 0);
#pragma unroll
                for (int g4 = 0; g4 < 4; ++g4) { float v[4];
#pragma unroll
                    for (int e = 0; e < 4; ++e) { float x = iw * fmaxf(acc[4 * g4 + e], 0.f); x += dpp_f(x, 0); x += dpp_f(x, 1); v[e] = x; }
                    float sel = hh == 0 ? v[0] : hh == 1 ? v[1] : hh == 2 ? v[2] : v[3];
                    sel = (sel == 0.f) ? 0.f : sel;
                    const int kv = 32 * tile + 8 * g4 + 4 * hi + hh;
                    sc[qq * SC_PITCH + kv + (kv >> 6)] = sel; } } }
    }
    __syncthreads();
    {
        const int t = t0 + wave; unsigned short* out = F.idx() + (tokb + t) * 256;
        if (t < 256) {
#pragma unroll
            for (int j = 0; j < 4; ++j) { const int kv = j * 64 + lane; out[kv] = (unsigned short)((kv <= t) ? kv : 0xFFFF); }
        } else {
            const LAS float* s = sc + wave * SC_PITCH + lane * 65;
            unsigned a[64];
            int lim = t - 64 * lane; asm volatile("" : "+v"(lim));
#pragma unroll
            for (int j = 0; j < 64; ++j) { const unsigned bits = __float_as_uint(s[j]); a[j] = bits ^ ((bits >> 31) ? 0xFFFFFFFFu : 0x80000000u); }
            unsigned in0 = (lim >= 31) ? 0xFFFFFFFFu : (lim < 0 ? 0u : ((2u << lim) - 1u));
            unsigned in1 = (lim >= 63) ? 0xFFFFFFFFu : (lim < 32 ? 0u : ((2u << (lim - 32)) - 1u));
#pragma unroll
            for (int blk = 0; blk < 2; ++blk) {
#pragma unroll
                for (int st = 0; st < 5; ++st) { const int sh = 16 >> st; const unsigned m = (st == 0) ? 0x0000FFFFu : (st == 1) ? 0x00FF00FFu : (st == 2) ? 0x0F0F0F0Fu : (st == 3) ? 0x33333333u : 0x55555555u;
#pragma unroll
                    for (int k = 0; k < 32; ++k) { if ((k & sh) == 0) { const unsigned tt = ((a[32 * blk + k] >> sh) ^ a[32 * blk + k + sh]) & m; a[32 * blk + k] ^= (tt << sh); a[32 * blk + k + sh] ^= tt; } } }
            }
            unsigned gt0 = 0u, gt1 = 0u; int above = 0; bool done = false;
#pragma unroll
            for (int b = 31; b >= 0; --b) {
                if (!done) {
                    const unsigned p0 = a[b] & in0, p1 = a[32 + b] & in1;
                    const int c1 = wave_isum(__popc(p0) + __popc(p1));
                    if (above + c1 >= 256) { in0 = p0; in1 = p1; done = (above + c1 == 256); }
                    else { above += c1; gt0 |= p0; gt1 |= p1; in0 &= ~a[b]; in1 &= ~a[32 + b]; }
                }
            }
            const int need = 256 - above; const int neq = __popc(in0) + __popc(in1);
            const int eqr = wave_excl_scan(neq, lane);
            int take = min(neq, max(0, need - eqr));
            unsigned s0 = gt0, s1 = gt1;
            if (take == neq) { s0 |= in0; s1 |= in1; }
            else { while (take > 0) { if (in0) { const unsigned lb = in0 & (0u - in0); s0 |= lb; in0 ^= lb; } else { const unsigned lb = in1 & (0u - in1); s1 |= lb; in1 ^= lb; } --take; } }
            int pos = wave_excl_scan(__popc(s0) + __popc(s1), lane);
            LAS unsigned short* lst = (LAS unsigned short*)(F.lds + 8 * SC_PITCH * 4 + wave * 1024);
            const int kvb = 64 * lane;
            while (s0) { const int jj = __ffs(s0) - 1; if (pos < 256) lst[pos] = (unsigned short)(kvb + jj); ++pos; s0 &= s0 - 1u; }
            while (s1) { const int jj = __ffs(s1) - 1; if (pos < 256) lst[pos] = (unsigned short)(kvb + 32 + jj); ++pos; s1 &= s1 - 1u; }
            WBAR();
            *(v2u*)(out + 4 * lane) = *(const LAS v2u*)(lst + 4 * lane);
            WBAR();
        }
    }
    __syncthreads();
}
__device__ __forceinline__ void dsa_stream(Frame& F, int q0, int qstride, int nq, bool store_en, LAS unsigned char* wl, int lane) {
    const int c = lane & 15, g = lane >> 4, h = c & 7;
    hb16* QKV = F.BIG(); const unsigned short* IDX = F.idx();
    const float slope2 = exp2f(-(float)(h + 1)) * LOG2E;
    LAS unsigned short* ixl = (LAS unsigned short*)wl;
    LAS unsigned char* vl = wl + 1024;
    const LAS unsigned char* vrd = vl + (4 * g + ((lane & 15) >> 2)) * 144 + 4 * (lane & 3) * 2;
    const int vrow = lane >> 3, vpiece = lane & 7;
    int qcur = q0;
    { const v2u r = *(const v2u*)(IDX + (size_t)qcur * 256 + 4 * lane); *(LAS v2u*)(ixl + 4 * lane) = r; }
    WBAR();
    bf16x8 kC[8]; v4u vC[8]; bf16x8 kN[8]; v4u vN[8];
    bf16x8 qf0, qf1, qn0, qn1; v2u ixr = {0u, 0u};
    {   const long tokb = (long)(qcur >> 12) * SEQ; const unsigned t = (unsigned)(qcur & (SEQ - 1));
        const hb16* qp = QKV + (size_t)qcur * QP + COL_QC + 64 * h; qf0 = *(const bf16x8*)(qp + 8 * g); qf1 = *(const bf16x8*)(qp + 32 + 8 * g);
#pragma unroll
        for (int i = 0; i < 4; ++i) { unsigned kr = ixl[16 * i + c]; if (kr > t) kr = 0u; const hb16* kp = QKV + (tokb + kr) * QP + COL_KC; kC[2 * i] = *(const bf16x8*)(kp + 8 * g); kC[2 * i + 1] = *(const bf16x8*)(kp + 32 + 8 * g); }
#pragma unroll
        for (int p = 0; p < 8; ++p) { unsigned vr = ixl[vrow + 8 * p]; if (vr > t) vr = 0u; vC[p] = *(const v4u*)(QKV + (tokb + vr) * QP + COL_VC + vpiece * 8); }
    }
    qn0 = qf0; qn1 = qf1;
    float m = -INFINITY, l = 0.f; f32x4 o[4];
#pragma unroll
    for (int dt = 0; dt < 4; ++dt) o[dt] = (f32x4){0.f, 0.f, 0.f, 0.f};
    const int nchunks = 4 * nq;
#pragma unroll 1
    for (int n = 0; n < nchunks; ++n) {
        const int qi = n >> 2, ch = n & 3;
        const int t = qcur & (SEQ - 1);
        const LAS unsigned short* ixc = ixl + 256 * (qi & 1);
        if (n + 1 < nchunks) {
            const int qnx = (ch == 3) ? qcur + qstride : qcur; const long tokb = (long)(qnx >> 12) * SEQ; const unsigned tn = (unsigned)(qnx & (SEQ - 1));
            const LAS unsigned short* ixn = ixl + 256 * (((n + 1) >> 2) & 1) + 64 * ((n + 1) & 3);
#pragma unroll
            for (int i = 0; i < 4; ++i) { unsigned kr = ixn[16 * i + c]; if (kr > tn) kr = 0u; const hb16* kp = QKV + (tokb + kr) * QP + COL_KC; kN[2 * i] = *(const bf16x8*)(kp + 8 * g); kN[2 * i + 1] = *(const bf16x8*)(kp + 32 + 8 * g); }
#pragma unroll
            for (int p = 0; p < 8; ++p) { unsigned vr = ixn[vrow + 8 * p]; if (vr > tn) vr = 0u; vN[p] = *(const v4u*)(QKV + (tokb + vr) * QP + COL_VC + vpiece * 8); }
        }
        if (qi + 1 < nq) {
            const int qnx = qcur + qstride;
            if (ch == 0) ixr = *(const v2u*)(IDX + (size_t)qnx * 256 + 4 * lane);
            if (ch == 1) { *(LAS v2u*)(ixl + 256 * ((qi + 1) & 1) + 4 * lane) = ixr;
                const hb16* qp = QKV + (size_t)qnx * QP + COL_QC + 64 * h; qn0 = *(const bf16x8*)(qp + 8 * g); qn1 = *(const bf16x8*)(qp + 32 + 8 * g); }
        }
        f32x4 S[4];
#pragma unroll
        for (int i = 0; i < 4; ++i) {
            f32x4 acc = {0.f, 0.f, 0.f, 0.f};
            acc = __builtin_amdgcn_mfma_f32_16x16x32_bf16(kC[2 * i], qf0, acc, 0, 0, 0); acc = __builtin_amdgcn_mfma_f32_16x16x32_bf16(kC[2 * i + 1], qf1, acc, 0, 0, 0);
            const v2u i4 = *(const LAS v2u*)(ixc + 64 * ch + 16 * i + 4 * g);
            const int id0 = i4.x & 0xffff, id1 = i4.x >> 16, id2 = i4.y & 0xffff, id3 = i4.y >> 16;
            S[i][0] = (id0 <= t) ? acc[0] - slope2 * (float)(t - id0) : -INFINITY; S[i][1] = (id1 <= t) ? acc[1] - slope2 * (float)(t - id1) : -INFINITY;
            S[i][2] = (id2 <= t) ? acc[2] - slope2 * (float)(t - id2) : -INFINITY; S[i][3] = (id3 <= t) ? acc[3] - slope2 * (float)(t - id3) : -INFINITY;
        }
        float mc = -INFINITY;
#pragma unroll
        for (int i = 0; i < 4; ++i) mc = fmaxf(mc, fmaxf(fmaxf(S[i][0], S[i][1]), fmaxf(S[i][2], S[i][3])));
        mc = fmaxf(mc, __shfl_xor(mc, 16)); mc = fmaxf(mc, __shfl_xor(mc, 32));
        const float mn = fmaxf(m, mc); const float alpha = __builtin_amdgcn_exp2f(m - mn); m = mn;
        float ls = 0.f;
#pragma unroll
        for (int i = 0; i < 4; ++i)
#pragma unroll
            for (int e = 0; e < 4; ++e) { const float pz = __builtin_amdgcn_exp2f(S[i][e] - mn); S[i][e] = pz; ls += pz; }
        l = l * alpha + ls;
#pragma unroll
        for (int dt = 0; dt < 4; ++dt) o[dt] = o[dt] * alpha;
#pragma unroll
        for (int p = 0; p < 8; ++p) *(LAS v4u*)(vl + (vrow + 8 * p) * 144 + vpiece * 16) = vC[p];
        WBAR();
#pragma unroll
        for (int u2 = 0; u2 < 2; ++u2) {
            v4u pw; pw.x = pk2(S[2 * u2][0], S[2 * u2][1]); pw.y = pk2(S[2 * u2][2], S[2 * u2][3]); pw.z = pk2(S[2 * u2 + 1][0], S[2 * u2 + 1][1]); pw.w = pk2(S[2 * u2 + 1][2], S[2 * u2 + 1][3]);
            const bf16x8 pb = __builtin_bit_cast(bf16x8, pw);
#pragma unroll
            for (int dt = 0; dt < 4; ++dt) { const s16x4 lo = vtr(vrd + (32 * u2) * 144 + dt * 32), hh = vtr(vrd + (32 * u2 + 16) * 144 + dt * 32);
                o[dt] = __builtin_amdgcn_mfma_f32_16x16x32_bf16(cat8(lo, hh), pb, o[dt], 0, 0, 0); }
        }
        WBAR();
        if (ch == 3) {
            float lt = l; lt += __shfl_xor(lt, 16); lt += __shfl_xor(lt, 32);
            if (c < 8 && store_en) { const float inv = 1.f / lt; hb16* op = QKV + (size_t)qcur * QP + COL_QC + 64 * h + 4 * g;
#pragma unroll
                for (int dt = 0; dt < 4; ++dt) { v2u w; w.x = pk2(o[dt][0] * inv, o[dt][1] * inv); w.y = pk2(o[dt][2] * inv, o[dt][3] * inv); *(v2u*)(op + 16 * dt) = w; } }
            m = -INFINITY; l = 0.f;
#pragma unroll
            for (int dt = 0; dt < 4; ++dt) o[dt] = (f32x4){0.f, 0.f, 0.f, 0.f};
            qcur += qstride; qf0 = qn0; qf1 = qn1;
        }
#pragma unroll
        for (int i = 0; i < 8; ++i) { kC[i] = kN[i]; vC[i] = vN[i]; }
    }
}

#define XB_TMO      128
#define XB_XCNT(j)  (256  + 64 * (j))
#define XB_XSUB(j)  (1280 + 64 * (j))
#define XB_XGEN(j)  (2304 + 64 * (j))
#define XB_TOP      3328
#define XB_TOPGEN   3392
#define XCD_BAR_WORDS 3456
#define XB_SPIN_CAP (1u << 18)

__device__ __forceinline__ unsigned xb_ld(unsigned* p)              { return __hip_atomic_load(p, __ATOMIC_RELAXED, __HIP_MEMORY_SCOPE_AGENT); }
__device__ __forceinline__ unsigned xb_add(unsigned* p, unsigned v) { return __hip_atomic_fetch_add(p, v, __ATOMIC_RELAXED, __HIP_MEMORY_SCOPE_AGENT); }
__device__ __forceinline__ unsigned xb_xcc_id() { return (unsigned)__builtin_amdgcn_s_getreg((3 << 11) | 20) & 0xFu; }
#define XB_SPIN(cond, bar) do { unsigned _sp = 0; while (cond) { __builtin_amdgcn_s_sleep(1); \
    if ((++_sp & 255u) == 0u) { if (xb_ld(&(bar)[XB_TMO])) break; if (_sp > XB_SPIN_CAP) { atomicAdd(&(bar)[XB_TMO], 1u); break; } } } } while (0)

struct XcdBarrier {
    unsigned* bar; unsigned x;
    volatile LAS unsigned* st;
};

__device__ __forceinline__ XcdBarrier xcd_barrier_post(unsigned* bar, volatile LAS unsigned* st) {
    XcdBarrier b; b.bar = bar; b.x = xb_xcc_id(); b.st = st;
    if (threadIdx.x == 0) (void)xb_add(&bar[XB_XCNT(b.x)], 1u);
    return b;
}
__device__ __forceinline__ void xcd_barrier_complete(unsigned* bar, unsigned x, unsigned& nloc, unsigned& nx) {
    const unsigned G = gridDim.x * gridDim.y * gridDim.z;
    unsigned sum, cnt, mine, sp = 0u;
    for (;;) {
        sum = 0u; cnt = 0u; mine = 0u;
#pragma unroll
        for (unsigned j = 0; j < 16; ++j) { const unsigned c = xb_ld(&bar[XB_XCNT(j)]); sum += c; cnt += (c > 0u) ? 1u : 0u; mine = (j == x) ? c : mine; }
        if (sum == G) break;
        __builtin_amdgcn_s_sleep(1);
        if ((++sp & 255u) == 0u) { if (xb_ld(&bar[XB_TMO])) break; if (sp > XB_SPIN_CAP) { atomicAdd(&bar[XB_TMO], 1u); break; } }
    }
    nloc = mine > 0u ? mine : 1u; nx = cnt > 0u ? cnt : 1u;
}

__device__ __forceinline__ void xcd_barrier(const XcdBarrier& b) {
    asm volatile("s_waitcnt vmcnt(0)" ::: "memory");
    __syncthreads();
    if (threadIdx.x == 0) {
        unsigned* bar = b.bar;
        __builtin_amdgcn_s_waitcnt(0);
        unsigned nloc = b.st[0], nx = b.st[1];
        if (nloc == 0u) { xcd_barrier_complete(bar, b.x, nloc, nx); b.st[0] = nloc; b.st[1] = nx; }
        const unsigned old = xb_add(&bar[XB_XSUB(b.x)], 1u);
        const unsigned gen = old / nloc;
        if (old + 1u == (gen + 1u) * nloc) {
            __builtin_amdgcn_fence(__ATOMIC_RELEASE, "agent");
            asm volatile("s_waitcnt vmcnt(0)" ::: "memory");
            const unsigned og = xb_add(&bar[XB_TOP], 1u);
            const unsigned tg = og / nx;
            if (og + 1u == (tg + 1u) * nx) xb_add(&bar[XB_TOPGEN], 1u);
            else XB_SPIN(xb_ld(&bar[XB_TOPGEN]) == tg, bar);
            __builtin_amdgcn_fence(__ATOMIC_ACQUIRE, "agent");
            xb_add(&bar[XB_XGEN(b.x)], 1u);
            asm volatile("s_waitcnt vmcnt(0)" ::: "memory");
        } else {
            XB_SPIN(xb_ld(&bar[XB_XGEN(b.x)]) == gen, bar);
            __builtin_amdgcn_fence(__ATOMIC_ACQUIRE, "agent");
            asm volatile("s_waitcnt vmcnt(0)" ::: "memory");
        }
    }
    __syncthreads();
}

constexpr int N_PHASES = 1 + 10 * NLAYER;
#ifndef DBG_MASK
#define DBG_MASK 0x7ff
#endif
#ifndef DBG_SUB
#define DBG_SUB 7
#endif
#define DBGK(k) (((DBG_MASK) >> (k)) & 1)
#define DSUB(k) (((DBG_SUB) >> (k)) & 1)
#ifndef PRB_G1
#define PRB_G1 1
#endif
#ifndef PRB_BAND
#define PRB_BAND 1
#endif
#ifndef PRB_IDX
#define PRB_IDX 1
#endif
#ifndef PRB_FOX
#define PRB_FOX 1
#endif
#ifndef PRB_DSA
#define PRB_DSA 1
#endif
#ifndef PRB_G2
#define PRB_G2 1
#endif
#ifndef PRB_G3
#define PRB_G3 1
#endif
#ifndef PRB_G4
#define PRB_G4 1
#endif
#ifndef PRB_G5
#define PRB_G5 1
#endif
#ifndef PRB_LN
#define PRB_LN 1
#endif
#ifndef USE_CG_FIRST
#define USE_CG_FIRST 1
#endif
#ifndef TS_A
#define TS_A -1
#endif
#ifndef TS_B
#define TS_B -1
#endif
#ifndef PRB_SYNC
#define PRB_SYNC 1
#endif
#ifndef PRB_CVT
#define PRB_CVT 1
#endif

__global__ void __launch_bounds__(NWAVES * 64, 2) mixer_fwd(Args args) {
    extern __shared__ __attribute__((aligned(16))) unsigned char lds[];
    cg::grid_group grid = cg::this_grid();
    const int lo = args.ph_lo, hi = args.ph_hi;
    volatile LAS unsigned* bst = (volatile LAS unsigned*)((LAS unsigned char*)lds + LDS_BYTES - 64);
    if (threadIdx.x < 16) bst[threadIdx.x] = 0u;
    __syncthreads();
    XcdBarrier xbar; xbar.bar = (unsigned*)(args.ws + WS_CTL); xbar.x = 0; xbar.st = bst;
    if (hi - lo > 1) xbar = xcd_barrier_post((unsigned*)(args.ws + WS_CTL), bst);
    if (TS_A >= 0 && blockIdx.x == 0 && threadIdx.x == 0) ((unsigned long long*)(args.ws + WS_CTL + 14336))[0] = __builtin_amdgcn_s_memrealtime();
#pragma unroll 1
    for (int ph = lo; ph < hi; ++ph) {
        Frame F;
        { int tid_ = threadIdx.x; asm volatile("" : "+v"(tid_)); F.tid = tid_; }
        F.lds = (LAS unsigned char*)lds; F.lane = F.tid & 63; F.wave = __builtin_amdgcn_readfirstlane(F.tid >> 6);
        F.G = gridDim.x; { const int bx = blockIdx.x; F.vcu = (F.G % 8 == 0) ? (bx % 8) * (F.G / 8) + bx / 8 : bx; }
        { unsigned char* wsp = args.ws; float* outp = args.out; asm volatile("" : "+s"(wsp), "+s"(outp)); F.ws = wsp; F.out = outp; }
        const int gw = F.vcu * NWAVES + F.wave;
        LAS unsigned char* wl = F.lds + F.wave * 16384;
        const int l = (ph == 0) ? 0 : (ph - 1) / 10, k = (ph == 0) ? 10 : (ph - 1) % 10;
        switch (k) {
        case 10:
            if (DBGK(10)) { for (int rp = 0; rp < PRB_CVT; ++rp) convert_weights(F, args, 0); x_to_bf16(F, args.in[0]); }
            break;
        case 0:
            if (DBGK(0)) {
                pg8::GridSched S; S.g = pg8::Gemm{F.XB(), F.Win_t(), DM, DM}; S.so.init(T, QP, F.G, (int)blockIdx.x);
                pg8::EpiBf16 E{F.BIG(), QP, F.side(), 18};
                for (int rp = 0; rp < PRB_G1; ++rp) pg8::gemm_phase<pg8::EpiBf16, pg8::GridSched, true>(F.lds, S, E);
            }
            break;
        case 1:
            if (DBGK(1)) {
                if (DSUB(0) && blockIdx.x < 32) cumsum_task(F, args.in[2] + l * 8, (int)blockIdx.x);
                if (DSUB(1)) for (int u = gw; u < 4096; u += F.G * NWAVES) {
                    const int h = u & 7, blk = (u >> 3) & 127, b = u >> 10; const long tb = (long)b * SEQ;
                    banded_unit<0>(F.BIG() + COL_QA + 64 * h, F.BIG() + COL_KA + 64 * (h >> 2), F.BIG() + COL_VA + 64 * (h >> 2), tb, 1, 32 * blk, slope_of(0, h) * LOG2E, 127,
                                   args.in[3][l * 8 + h] * LOG2E, true, F.BIG() + COL_QA + 64 * h, nullptr, nullptr, nullptr, nullptr, nullptr, nullptr, wl, F.lane);
                    for (int rp = 0; rp < PRB_BAND; ++rp) banded_unit<1>(F.BIG() + COL_QB + 64 * h, F.BIG() + COL_KB + 64 * h, F.BIG() + COL_VB + 64 * h, tb, 1, 32 * blk, slope_of(1, h) * LOG2E, 128, 0.f, false,
                                   nullptr, F.pu1() + 64 * h, F.pml1() + 2 * h, nullptr, nullptr, nullptr, nullptr, wl, F.lane);
                    for (int rp = 0; rp < PRB_BAND; ++rp) banded_unit<1>(F.BIG() + COL_QB + 64 * h, F.BIG() + COL_KB + 64 * h, F.BIG() + COL_VB + 64 * h, tb + (blk & 3), 4, 32 * (blk >> 2), slope_of(1, h) * 4.f * LOG2E, 128, 0.f, false,
                                   nullptr, F.pu2() + 64 * h, F.pml2() + 2 * h, nullptr, nullptr, nullptr, nullptr, wl, F.lane);
                }
                __syncthreads();
                if (DSUB(2)) for (int rp = 0; rp < PRB_IDX; ++rp) for (int b = 0; b < NB; ++b) { const int c = (int)blockIdx.x; if (c < 256) { indexer_step(F, b, c); indexer_step(F, b, 511 - c); } }
            }
            break;
        case 2:
            if (DBGK(2)) {
                if (DSUB(0)) for (int rp = 0; rp < PRB_FOX; ++rp) for (int i = 0; i < 2; ++i) { const int v = F.vcu; if (v < 256) { const int s = v & 7, bh = v >> 3, qb = (i == 0) ? s : 15 - s;
                    fox::attn_unit<8>(bh >> 3, bh & 7, qb, (const fox::bf16*)(F.BIG() + COL_QD), (const fox::bf16*)(F.BIG() + COL_KD), (const fox::bf16*)(F.BIG() + COL_VD), (fox::bf16*)(F.BIG() + COL_QD), F.cb(), rp == PRB_FOX - 1, (char*)lds); } }
                __syncthreads();
                if (DSUB(1)) for (int rp = 0; rp < PRB_DSA; ++rp) dsa_stream(F, gw, F.G * NWAVES, T / (F.G * NWAVES), rp == PRB_DSA - 1, wl, F.lane);
                if (DSUB(2)) for (int u = gw; u < 4096; u += F.G * NWAVES) {
                    const int h = u & 7, blk = (u >> 3) & 127, b = u >> 10; const long tb = (long)b * SEQ;
                    banded_unit<2>(F.BIG() + COL_QB + 64 * h, F.BIG() + COL_KB + 64 * h, F.BIG() + COL_VB + 64 * h, tb + (blk & 15), 16, 32 * (blk >> 4), slope_of(1, h) * 16.f * LOG2E, 128, 0.f, false,
                                   F.BIG() + COL_QB + 64 * h, nullptr, nullptr, F.pu1() + 64 * h, F.pml1() + 2 * h, F.pu2() + 64 * h, F.pml2() + 2 * h, wl, F.lane);
                }
            }
            break;
        case 3:
            if (DBGK(3)) {
                pg8::StaticOrder S; S.init(T, DM, F.G, (int)blockIdx.x);
                pg8::GateProjSched GS; GS.have = S.next(0, GS.u0); GS.X = F.XB(); GS.Wg = F.Wg_t(); GS.O = F.BIG(); GS.Wb = F.Wb_t(); GS.ldo = QP;
                unsigned char* scr = (unsigned char*)F.out + (size_t)blockIdx.x * 131072;
                pg8::EpiGateProj E{scr, args.in[6] + (size_t)l * 4096, F.BIG() + COL_MRG, QP};
                for (int rp = 0; rp < PRB_G2; ++rp) pg8::gemm_phase<pg8::EpiGateProj, pg8::GateProjSched, true>(F.lds, GS, E);
            }
            break;
        case 4:
            if (DBGK(4)) {
                pg8::GridSched S; S.g = pg8::Gemm{F.BIG() + COL_MRG, F.Wo_t(), QP, DM}; S.so.init(T, DM, F.G, (int)blockIdx.x);
                pg8::EpiResF32 E{F.XB(), DM, F.out, DM, ALPHA};
                for (int rp = 0; rp < PRB_G3; ++rp) pg8::gemm_phase<pg8::EpiResF32, pg8::GridSched, false>(F.lds, S, E);
            }
            break;
        case 5:
            if (DBGK(5)) for (int rp = 0; rp < PRB_LN; ++rp) ln_phase(F, args.in[8] + (size_t)l * DM, args.in[9] + (size_t)l * DM, false);
            break;
        case 6:
            if (DBGK(6)) {
                pg8::GridSched S; S.g = pg8::Gemm{F.XB(), F.Wuf_t(), DM, DM}; S.so.init(T, FP, F.G, (int)blockIdx.x);
                pg8::EpiBf16 E{F.BIG(), FP, nullptr, -1};
                for (int rp = 0; rp < PRB_G4; ++rp) pg8::gemm_phase<pg8::EpiBf16, pg8::GridSched, true>(F.lds, S, E);
            }
            break;
        case 7:
            if (DBGK(7)) ffn_elem_phase(F, args.in[12] + (size_t)l * 3 * DFF, args.in[13] + (size_t)l * DFF);
            break;
        case 8:
            if (DBGK(8)) {
                pg8::GridSched S; S.g = pg8::Gemm{F.BIG() + DFF, F.Wd_t(), FP, DFF}; S.so.init(T, DM, F.G, (int)blockIdx.x);
                pg8::EpiResF32 E{F.XB(), DM, F.out, DM, ALPHA};
                for (int rp = 0; rp < PRB_G5; ++rp) pg8::gemm_phase<pg8::EpiResF32, pg8::GridSched, false>(F.lds, S, E);
            }
            break;
        default:
            if (DBGK(9)) {
                ln_phase(F, args.in[15] + (size_t)l * DM, args.in[16] + (size_t)l * DM, l == NLAYER - 1);
                if (l + 1 < NLAYER) convert_weights(F, args, l + 1);
            }
            break;
        }
        if (ph + 1 < hi) for (int rp = 0; rp < PRB_SYNC; ++rp) { if (ph == lo && USE_CG_FIRST) grid.sync(); else { XcdBarrier b2; unsigned* bp = (unsigned*)(args.ws + WS_CTL); unsigned xx = xbar.x; asm volatile("" : "+s"(bp), "+s"(xx));
                b2.bar = bp; b2.x = xx; b2.st = bst; xcd_barrier(b2); } }
        if (TS_A >= 0 && blockIdx.x == 0 && threadIdx.x == 0) ((unsigned long long*)(args.ws + WS_CTL + 14336))[ph + 1] = __builtin_amdgcn_s_memrealtime();
    }
    if (TS_A >= 0) {
        { XcdBarrier b2; unsigned* bp = (unsigned*)(args.ws + WS_CTL); unsigned xx = xbar.x; asm volatile("" : "+s"(bp), "+s"(xx)); b2.bar = bp; b2.x = xx; b2.st = bst; xcd_barrier(b2); }
        const unsigned long long* ts = (const unsigned long long*)(args.ws + WS_CTL + 14336);
        const float usA = (float)(ts[TS_A + 1] - ts[TS_A]) * 0.01f;
        if (blockIdx.x == 0 && threadIdx.x == 0) args.out[0] += usA * 0.25f;
    }
}

#ifndef MK_ONE_LAUNCH
#define MK_ONE_LAUNCH 1
#endif
extern "C" void kernel_launch(void* const* d_in, const int* in_sizes, int n_in, void* d_out, int out_size, void* d_ws, size_t ws_size, hipStream_t stream) {
    static int grid = 0;
    if (grid == 0) {
        if (n_in != 17 || out_size != T * DM || ws_size < WS_END) { fprintf(stderr, "kernel_launch: unexpected shapes (n_in %d out %d ws %zu)\n", n_in, out_size, ws_size); grid = -1; return; }
        int dev = 0, cus = 0, per_cu = 0;
        if (hipGetDevice(&dev) != hipSuccess || hipDeviceGetAttribute(&cus, hipDeviceAttributeMultiprocessorCount, dev) != hipSuccess) { grid = -1; return; }
        if (hipFuncSetAttribute((const void*)mixer_fwd, hipFuncAttributeMaxDynamicSharedMemorySize, LDS_BYTES) != hipSuccess) { fprintf(stderr, "kernel_launch: hipFuncSetAttribute failed\n"); grid = -1; return; }
        if (hipOccupancyMaxActiveBlocksPerMultiprocessor(&per_cu, (const void*)mixer_fwd, NWAVES * 64, LDS_BYTES) != hipSuccess || per_cu < 1) { fprintf(stderr, "kernel_launch: occupancy query says %d\n", per_cu); per_cu = 1; }
        (void)hipGetLastError();
        grid = cus;
        if (grid != 256) fprintf(stderr, "kernel_launch: %d CUs (built for 256)\n", grid);
    }
    if (grid < 0) return;
    Args a{};
    for (int i = 0; i < 17; ++i) a.in[i] = (const float*)d_in[i];
    a.out = (float*)d_out; a.ws = (unsigned char*)d_ws;
#if MK_ONE_LAUNCH
    if (hipMemsetAsync((char*)d_ws + WS_CTL, 0, CTL_ZERO_BYTES, stream) != hipSuccess) { fprintf(stderr, "kernel_launch: memset failed\n"); return; }
    a.ph_lo = 0; a.ph_hi = N_PHASES;
    void* kargs[] = {&a};
    hipError_t e = hipLaunchCooperativeKernel((const void*)mixer_fwd, dim3(grid), dim3(NWAVES * 64), kargs, LDS_BYTES, stream);
    if (e != hipSuccess) fprintf(stderr, "kernel_launch: cooperative launch failed: %s\n", hipGetErrorString(e));
#else
    for (int p = 0; p < N_PHASES; ++p) {
        a.ph_lo = p; a.ph_hi = p + 1;
        hipLaunchKernelGGL(mixer_fwd, dim3(grid), dim3(NWAVES * 64), LDS_BYTES, stream, a);
    }
#endif
}
```
